# Optimizing an MI355X kernel written in HIP

```python
import jax, jax.numpy as jnp
from jax import lax
import numpy as np

D_MODEL = 1024
BATCH = 16
SEQ = 4096
DEPTH = 1
DEC_BATCH = 32
DEC_SEQ = 16
PAST_LEN = 4096

CHUNK = 64
Q_BLOCK = 128
N_HEADS = D_MODEL // 128
QK_NOPE = 64
QK_ROPE = 32
V_DIM = 64
KV_LORA = D_MODEL // 4
Q_LORA = 3 * KV_LORA
CONV_CH = D_MODEL // 2
CONV_W = 31
D_FF = 4 * D_MODEL
PLE_DIM = 256
ROPE_THETA = 10000.0
RMS_EPS = 1e-6
LN_EPS = 1e-5
SM_SCALE = (QK_NOPE + QK_ROPE) ** -0.5
NEG_INF = -1e30

OFF_KV = Q_LORA
OFF_KR = OFF_KV + KV_LORA
OFF_CONV = OFF_KR + QK_ROPE
OFF_GATE = OFF_CONV + 2 * CONV_CH
IN_W = OFF_GATE + 2 * D_MODEL

kernel_name = 'mla_conformer_parallel_stream_encoder_step'


def rmsnorm(x, g):
    xf = x.astype(jnp.float32)
    y = xf * lax.rsqrt(jnp.mean(xf * xf, axis=-1, keepdims=True) + RMS_EPS)
    return (y * g.astype(jnp.float32)).astype(x.dtype)


def layernorm(x, g, b):
    xf = x.astype(jnp.float32)
    mu = jnp.mean(xf, axis=-1, keepdims=True)
    xc = xf - mu
    y = xc * lax.rsqrt(jnp.mean(xc * xc, axis=-1, keepdims=True) + LN_EPS)
    return (y * g.astype(jnp.float32) + b.astype(jnp.float32)).astype(x.dtype)


def rope(x, pos):
    half = x.shape[-1] // 2
    inv = ROPE_THETA ** (-jnp.arange(half, dtype=jnp.float32) / half)
    ang = pos.astype(jnp.float32)[:, None] * inv[None, :]
    cos = jnp.cos(ang)[:, None, :]
    sin = jnp.sin(ang)[:, None, :]
    x1 = x[..., :half].astype(jnp.float32)
    x2 = x[..., half:].astype(jnp.float32)
    out = jnp.concatenate([x1 * cos - x2 * sin, x2 * cos + x1 * sin], axis=-1)
    return out.astype(x.dtype)


def attend(q_lat, q_rope, lat, kr, q_pos, k_pos):
    s = (jnp.einsum('bqhc,bkc->bhqk', q_lat, lat)
         + jnp.einsum('bqhr,bkr->bhqk', q_rope, kr)).astype(jnp.float32) * SM_SCALE
    mask = (k_pos // CHUNK)[None, :] <= (q_pos // CHUNK)[:, None]
    s = jnp.where(mask, s, NEG_INF)
    p = jax.nn.softmax(s, axis=-1).astype(lat.dtype)
    return jnp.einsum('bhqk,bkc->bqhc', p, lat)


def blocked_attend(q_lat, q_rope, lat, kr, q_pos, k_pos):
    B, T, H, C = q_lat.shape
    if T <= Q_BLOCK or T % Q_BLOCK != 0:
        return attend(q_lat, q_rope, lat, kr, q_pos, k_pos)
    nb = T // Q_BLOCK
    ql = q_lat.reshape(B, nb, Q_BLOCK, H, C).transpose(1, 0, 2, 3, 4)
    qr = q_rope.reshape(B, nb, Q_BLOCK, H, QK_ROPE).transpose(1, 0, 2, 3, 4)
    qp = q_pos.reshape(nb, Q_BLOCK)
    out = lax.map(lambda a: attend(a[0], a[1], lat, kr, a[2], k_pos), (ql, qr, qp))
    return out.transpose(1, 0, 2, 3, 4).reshape(B, T, H, C)


def encoder_layer(x, p_emb, q_pos, cache_lat, cache_kr, cache_cv,
                  norm_mix_g, w_in, q_norm_g, w_uq, kv_norm_g, w_uk, w_uv, w_attn_out,
                  conv_w, conv_b, conv_ln_g, conv_ln_b, w_conv_out, w_out,
                  norm_ffn_g, w_ff_up, w_ff_down, ple_norm_g, w_ple_gate, w_ple_proj):
    B, T, _ = x.shape
    h = rmsnorm(x, norm_mix_g)
    z = h @ w_in
    c_q = z[..., :OFF_KV]
    c_kv = z[..., OFF_KV:OFF_KR]
    k_r = z[..., OFF_KR:OFF_CONV]
    u2 = z[..., OFF_CONV:OFF_GATE]
    g = z[..., OFF_GATE:]

    q = jnp.einsum('bsc,chd->bshd', rmsnorm(c_q, q_norm_g), w_uq)
    q_nope = q[..., :QK_NOPE]
    q_rope = rope(q[..., QK_NOPE:], q_pos)
    q_lat = jnp.einsum('bshd,chd->bshc', q_nope, w_uk)
    latent = rmsnorm(c_kv, kv_norm_g)
    k_rope = rope(k_r[:, :, None, :], q_pos)[:, :, 0, :]
    if cache_lat is None:
        lat_all, kr_all, k_pos = latent, k_rope, q_pos
        u_hist = jnp.zeros((B, CONV_W - 1, CONV_CH), x.dtype)
    else:
        lat_all = jnp.concatenate([cache_lat, latent], axis=1)
        kr_all = jnp.concatenate([cache_kr, k_rope], axis=1)
        k_pos = jnp.arange(cache_lat.shape[1] + T)
        u_hist = cache_cv
    o_lat = blocked_attend(q_lat, q_rope, lat_all, kr_all, q_pos, k_pos)
    o = jnp.einsum('bshc,chd->bshd', o_lat, w_uv).reshape(B, T, N_HEADS * V_DIM)
    attn_branch = o @ w_attn_out

    u = u2[..., :CONV_CH] * jax.nn.sigmoid(u2[..., CONV_CH:])
    u_ext = jnp.concatenate([u_hist, u], axis=1)
    dw = lax.conv_general_dilated(u_ext, conv_w[:, None, :], (1,), 'VALID',
                                  dimension_numbers=('NWC', 'WIO', 'NWC'),
                                  feature_group_count=CONV_CH) + conv_b
    conv_branch = jax.nn.silu(layernorm(dw, conv_ln_g, conv_ln_b)) @ w_conv_out

    gate_a = jax.nn.sigmoid(g[..., :D_MODEL])
    gate_c = jax.nn.sigmoid(g[..., D_MODEL:])
    x = x + (gate_a * attn_branch + gate_c * conv_branch) @ w_out

    x = x + jnp.square(jax.nn.relu(rmsnorm(x, norm_ffn_g) @ w_ff_up)) @ w_ff_down

    x = x + jax.nn.sigmoid(rmsnorm(x, ple_norm_g) @ w_ple_gate) * (p_emb @ w_ple_proj)
    return x, latent, k_rope, u_ext[:, -(CONV_W - 1):]


def setup_inputs(seed: int = 0) -> dict:
    key = jax.random.key(seed)
    ks = jax.random.split(key, 32)
    f32 = jnp.float32
    L = DEPTH

    def nrm(k, shape, scale):
        return jax.random.normal(k, shape, f32) * scale

    def gain(k, n):
        return 1.0 + 0.1 * jax.random.normal(k, (L, n), f32)

    return {
        'x_prompt': nrm(ks[0], (BATCH, SEQ, D_MODEL), 1.0),
        'x_sample': nrm(ks[1], (DEC_BATCH, DEC_SEQ, D_MODEL), 1.0),
        'p_prompt': nrm(ks[2], (L, BATCH, SEQ, PLE_DIM), 1.0),
        'p_sample': nrm(ks[3], (L, DEC_BATCH, DEC_SEQ, PLE_DIM), 1.0),
        'cache_kv_latent': nrm(ks[4], (L, DEC_BATCH, PAST_LEN, KV_LORA), 1.0),
        'cache_k_rope': nrm(ks[5], (L, DEC_BATCH, PAST_LEN, QK_ROPE), 1.0),
        'cache_conv': nrm(ks[6], (L, DEC_BATCH, CONV_W - 1, CONV_CH), 0.5),
        'norm_mix_g': gain(ks[7], D_MODEL),
        'w_in': nrm(ks[8], (L, D_MODEL, IN_W), D_MODEL ** -0.5),
        'q_norm_g': gain(ks[9], Q_LORA),
        'w_uq': nrm(ks[10], (L, Q_LORA, N_HEADS, QK_NOPE + QK_ROPE), Q_LORA ** -0.5),
        'kv_norm_g': gain(ks[11], KV_LORA),
        'w_uk': nrm(ks[12], (L, KV_LORA, N_HEADS, QK_NOPE), KV_LORA ** -0.5),
        'w_uv': nrm(ks[13], (L, KV_LORA, N_HEADS, V_DIM), KV_LORA ** -0.5),
        'w_attn_out': nrm(ks[14], (L, N_HEADS * V_DIM, D_MODEL), (N_HEADS * V_DIM) ** -0.5),
        'conv_w': nrm(ks[15], (L, CONV_W, CONV_CH), CONV_W ** -0.5),
        'conv_b': nrm(ks[16], (L, CONV_CH), 0.01),
        'conv_ln_g': gain(ks[17], CONV_CH),
        'conv_ln_b': nrm(ks[18], (L, CONV_CH), 0.01),
        'w_conv_out': nrm(ks[19], (L, CONV_CH, D_MODEL), CONV_CH ** -0.5),
        'w_out': nrm(ks[20], (L, D_MODEL, D_MODEL), D_MODEL ** -0.5),
        'norm_ffn_g': gain(ks[21], D_MODEL),
        'w_ff_up': nrm(ks[22], (L, D_MODEL, D_FF), D_MODEL ** -0.5),
        'w_ff_down': nrm(ks[23], (L, D_FF, D_MODEL), D_FF ** -0.5),
        'ple_norm_g': gain(ks[24], D_MODEL),
        'w_ple_gate': nrm(ks[25], (L, D_MODEL, D_MODEL), D_MODEL ** -0.5),
        'w_ple_proj': nrm(ks[26], (L, PLE_DIM, D_MODEL), PLE_DIM ** -0.5),
        'final_norm_g': 1.0 + 0.1 * jax.random.normal(ks[27], (D_MODEL,), f32),
    }


def reference(x_prompt, x_sample, p_prompt, p_sample, cache_kv_latent, cache_k_rope, cache_conv,
              norm_mix_g, w_in, q_norm_g, w_uq, kv_norm_g, w_uk, w_uv, w_attn_out,
              conv_w, conv_b, conv_ln_g, conv_ln_b, w_conv_out, w_out,
              norm_ffn_g, w_ff_up, w_ff_down, ple_norm_g, w_ple_gate, w_ple_proj, final_norm_g):
    t_prompt = x_prompt.shape[1]
    t_sample = x_sample.shape[1]
    past = cache_kv_latent.shape[2]
    pos_p = jnp.arange(t_prompt)
    pos_s = past + jnp.arange(t_sample)
    xp, xs = x_prompt, x_sample
    lat_p, kr_p, cv_p, lat_s, kr_s, cv_s = [], [], [], [], [], []
    for i in range(DEPTH):
        lw = (norm_mix_g[i], w_in[i], q_norm_g[i], w_uq[i], kv_norm_g[i], w_uk[i], w_uv[i],
              w_attn_out[i], conv_w[i], conv_b[i], conv_ln_g[i], conv_ln_b[i], w_conv_out[i],
              w_out[i], norm_ffn_g[i], w_ff_up[i], w_ff_down[i], ple_norm_g[i], w_ple_gate[i],
              w_ple_proj[i])
        xp, a, b, c = encoder_layer(xp, p_prompt[i], pos_p, None, None, None, *lw)
        lat_p.append(a)
        kr_p.append(b)
        cv_p.append(c)
        xs, a, b, c = encoder_layer(xs, p_sample[i], pos_s, cache_kv_latent[i], cache_k_rope[i],
                                    cache_conv[i], *lw)
        lat_s.append(a)
        kr_s.append(b)
        cv_s.append(c)
    y_prompt = rmsnorm(xp, final_norm_g)
    y_sample = rmsnorm(xs, final_norm_g)
    return (y_prompt, y_sample, jnp.stack(lat_p), jnp.stack(kr_p), jnp.stack(cv_p),
            jnp.stack(lat_s), jnp.stack(kr_s), jnp.stack(cv_s))
```

```cpp
#include <hip/hip_runtime.h>
#include <hip/hip_cooperative_groups.h>
#include <cstdio>
#include <cstdint>
#include <cmath>
namespace cg = cooperative_groups;
namespace pg8 {
#define PG8_LAS __attribute__((address_space(3)))
typedef unsigned short bf16_t;
typedef short bf16x8 __attribute__((ext_vector_type(8)));
typedef float f32x4 __attribute__((ext_vector_type(4)));
typedef unsigned u32x4 __attribute__((ext_vector_type(4)));
constexpr int BM = 256, BK = 64, HALF = 128, HTB = HALF * BK * 2  , STAGE_BYTES = 8 * HTB, NXCD = 8, WGM = 8;

__host__ __device__ __forceinline__ int lds_byte(int r, int c) { const int st = (r >> 4) * 2 + (c >> 5), rr = r & 15, cc = c & 31, ob = rr * 64 + cc * 2; return st * 1024 + (ob ^ (((ob >> 9) & 1) << 5)); }
__host__ __device__ __forceinline__ void stage_rc(int b, int& R, int& C) { const int st = b / 1024, sb = b % 1024, swz = sb ^ (((sb >> 9) & 1) << 5); R = (st >> 1) * 16 + swz / 64; C = (st & 1) * 32 + (swz % 64) / 2; }
__host__ __device__ __forceinline__ int perm32(int rho) { const int n = rho >> 4, i = rho & 15; return 8 * (i >> 2) + 4 * n + (i & 3); }

struct Unit { int pm, pn; };
struct Gemm { const bf16_t* A; const bf16_t* Bt; int M, N, K, lda, ldb; };

struct StaticOrder {
    int nM, nN, nwg, G, c;
    __host__ __device__ void init(int M, int N, int G_, int c_) { nM = M / BM; nN = N / BM; nwg = nM * nN; G = G_; c = c_; }
    __host__ __device__ bool next(int i, Unit& u) const {
        const long L = (long)i * G + c; if (L >= nwg) return false;
        int wgid = (int)L; { const int q = nwg / NXCD, r = nwg % NXCD, xcd = wgid % NXCD, off = wgid / NXCD; wgid = (xcd < r ? xcd * (q + 1) : r * (q + 1) + (xcd - r) * q) + off; }
        const int nig = WGM * nN, gid = wgid / nig, fm = gid * WGM, gsz = (nM - fm) < WGM ? (nM - fm) : WGM;
        u.pm = fm + ((wgid % nig) % gsz); u.pn = (wgid % nig) / gsz; return true;
    }
    __device__ __forceinline__ void a_ready(const Unit&) const {}
    __device__ __forceinline__ void done(const Unit&) const {}
};

__device__ __forceinline__ unsigned cvt_pk_bf16(float lo, float hi) { unsigned r; asm volatile("v_cvt_pk_bf16_f32 %0, %1, %2" : "=v"(r) : "v"(lo), "v"(hi)); return r; }
template <class Epi, class Sched, bool ALIGN_EPI = false, bool SP2 = false>
__device__ __forceinline__ void gemm_phase(PG8_LAS unsigned char* lds, const Gemm g, const Sched& S, const Epi& E) {
    const int tid = threadIdx.x, wid = __builtin_amdgcn_readfirstlane(tid >> 6), lane = tid & 63, wr = wid >> 2, wc = wid & 3, fr = lane & 15, fq = lane >> 4;
    const int K = g.K, nt = K / BK, LDA = g.lda, LDB = g.ldb;
    unsigned voffA[2], voffB[2];
#pragma unroll
    for (int i = 0; i < 2; ++i) { int R, C; stage_rc(tid * 16 + i * 8192, R, C); const int Rb = Epi::PERM ? ((R & ~31) + perm32(R & 31)) : R;
        voffA[i] = (unsigned)(R * LDA + C) * 2u; voffB[i] = (unsigned)(Rb * LDB + C) * 2u; }
    const size_t kstep = (size_t)(BK * 2);
    const size_t hstepA = (size_t)HALF * LDA * 2, hstepB = (size_t)HALF * LDB * 2;
    const size_t tstepA = 2 * hstepA, tstepB = 2 * hstepB;
    const unsigned ldsw = (unsigned)wid * 1024u;
    const int aoff = lds_byte(wr * 64 + fr, fq * 8), boff = lds_byte(wc * 32 + fr, fq * 8);
#define PG8_SA(b, h) (((b) * 2 + (h)) * HTB)
#define PG8_SB(b, h) ((4 + (b) * 2 + (h)) * HTB)
#define PG8_STAGE(bufoff, gbase, voff) do { _Pragma("unroll") for (int _i = 0; _i < 2; ++_i) \
        __builtin_amdgcn_global_load_lds((const unsigned*)((const char*)(gbase) + (voff)[_i]), (PG8_LAS unsigned*)(lds + (bufoff) + ldsw + _i * 8192), 16, 0, 0); } while (0)
#define PG8_LDA(dst, b, h) do { _Pragma("unroll") for (int m = 0; m < 4; ++m) _Pragma("unroll") for (int k = 0; k < 2; ++k) dst[m][k] = *(const PG8_LAS bf16x8*)(lds + PG8_SA(b, h) + aoff + m * 2048 + k * 1024); } while (0)
#define PG8_LDB(dst, b, h) do { _Pragma("unroll") for (int n = 0; n < 2; ++n) _Pragma("unroll") for (int k = 0; k < 2; ++k) dst[n][k] = *(const PG8_LAS bf16x8*)(lds + PG8_SB(b, h) + boff + n * 2048 + k * 1024); } while (0)
#define PG8_MMA(ai, bj, At, Bt) do { __builtin_amdgcn_s_setprio(1); _Pragma("unroll") for (int m = 0; m < 4; ++m) _Pragma("unroll") for (int n = 0; n < 2; ++n) _Pragma("unroll") for (int k = 0; k < 2; ++k) \
        acc[ai][bj][m][n] = __builtin_amdgcn_mfma_f32_16x16x32_bf16(Bt[n][k], At[m][k], acc[ai][bj][m][n], 0, 0, 0); __builtin_amdgcn_s_setprio(0); } while (0)
#define PG8_WAIT_V(n) asm volatile("s_waitcnt vmcnt(" #n ")" ::: "memory")
#define PG8_WAIT_L(n) asm volatile("s_waitcnt lgkmcnt(" #n ")" ::: "memory")
#define PG8_BAR __builtin_amdgcn_s_barrier()
#define PG8_SCHED __builtin_amdgcn_sched_barrier(0)
    Unit cur, nxt; int ui = 0;
    if (!S.next(0, cur)) return;
    f32x4 acc[2][2][4][2];
#pragma unroll
    for (int a = 0; a < 2; ++a)
#pragma unroll
        for (int b = 0; b < 2; ++b)
#pragma unroll
            for (int m = 0; m < 4; ++m)
#pragma unroll
                for (int n = 0; n < 2; ++n) acc[a][b][m][n] = (f32x4){0.f, 0.f, 0.f, 0.f};
    bf16x8 At[4][2], B0[2][2], B1[2][2];
    const char* cA = (const char*)g.A + (size_t)cur.pm * tstepA; const char* cB = (const char*)g.Bt + (size_t)cur.pn * tstepB;
    S.a_ready(cur);
    if constexpr (SP2) {
        PG8_STAGE(PG8_SB(0, 0), cB, voffB); PG8_STAGE(PG8_SB(0, 1), cB + hstepB, voffB); PG8_STAGE(PG8_SA(0, 0), cA, voffA); PG8_STAGE(PG8_SA(0, 1), cA + hstepA, voffA);
        if (wr == 1) PG8_BAR;
        PG8_WAIT_V(2); PG8_BAR;
        PG8_STAGE(PG8_SB(1, 0), cB + kstep, voffB); PG8_STAGE(PG8_SA(1, 0), cA + kstep, voffA); PG8_STAGE(PG8_SB(1, 1), cB + hstepB + kstep, voffB);
        PG8_WAIT_V(6); PG8_BAR;
    } else {
        PG8_STAGE(PG8_SB(0, 0), cB, voffB); PG8_STAGE(PG8_SA(0, 0), cA, voffA); PG8_STAGE(PG8_SB(0, 1), cB + hstepB, voffB); PG8_STAGE(PG8_SA(0, 1), cA + hstepA, voffA);
        if (wr == 1) PG8_BAR;
        PG8_WAIT_V(4); PG8_BAR;
        PG8_STAGE(PG8_SB(1, 0), cB + kstep, voffB); PG8_STAGE(PG8_SA(1, 0), cA + kstep, voffA); PG8_STAGE(PG8_SB(1, 1), cB + hstepB + kstep, voffB);
        PG8_WAIT_V(6); PG8_BAR;
    }
    for (;;) {
        const bool has_next = S.next(ui + 1, nxt);
        const char* nA = has_next ? (const char*)g.A + (size_t)nxt.pm * tstepA : cA; const char* nB = has_next ? (const char*)g.Bt + (size_t)nxt.pn * tstepB : cB;
#pragma unroll 1
        for (int t = 0; t < nt; t += 2) {
            const bool last = (t == nt - 2);
            const char* a1 = cA + (size_t)(t + 1) * kstep;
            const char* a2 = last ? nA : cA + (size_t)(t + 2) * kstep; const char* b2 = last ? nB : cB + (size_t)(t + 2) * kstep;
            const char* a3 = a2 + kstep; const char* b3 = b2 + kstep;
            if (last && has_next) S.a_ready(nxt);
            if constexpr (SP2) {
            PG8_LDB(B0, 0, 0); PG8_LDB(B1, 0, 1); PG8_SCHED; PG8_LDA(At, 0, 0); PG8_STAGE(PG8_SA(1, 1), a1 + hstepA, voffA);
            PG8_WAIT_V(8); PG8_WAIT_L(0); PG8_BAR; PG8_MMA(0, 0, At, B0); PG8_MMA(0, 1, At, B1); PG8_BAR; PG8_SCHED;
            PG8_LDA(At, 0, 1); PG8_STAGE(PG8_SB(0, 0), b2, voffB); PG8_STAGE(PG8_SB(0, 1), b2 + hstepB, voffB); PG8_STAGE(PG8_SA(0, 0), a2, voffA);
            PG8_WAIT_V(8); PG8_WAIT_L(0); PG8_BAR; PG8_MMA(1, 0, At, B0); PG8_MMA(1, 1, At, B1); PG8_BAR; PG8_SCHED;
            PG8_LDB(B0, 1, 0); PG8_LDB(B1, 1, 1); PG8_SCHED; PG8_LDA(At, 1, 0); PG8_STAGE(PG8_SA(0, 1), a2 + hstepA, voffA);
            PG8_WAIT_V(8); PG8_WAIT_L(0); PG8_BAR; PG8_MMA(0, 0, At, B0); PG8_MMA(0, 1, At, B1); PG8_BAR; PG8_SCHED;
            PG8_LDA(At, 1, 1); PG8_STAGE(PG8_SB(1, 0), b3, voffB); PG8_STAGE(PG8_SB(1, 1), b3 + hstepB, voffB); PG8_STAGE(PG8_SA(1, 0), a3, voffA);
            PG8_WAIT_V(8); PG8_WAIT_L(0); PG8_BAR; PG8_MMA(1, 0, At, B0); PG8_MMA(1, 1, At, B1); PG8_BAR; PG8_SCHED;
            } else {
            PG8_LDB(B0, 0, 0); PG8_SCHED; PG8_LDA(At, 0, 0); PG8_STAGE(PG8_SA(1, 1), a1 + hstepA, voffA);
            PG8_WAIT_L(8); PG8_BAR; PG8_WAIT_L(0); PG8_MMA(0, 0, At, B0); PG8_BAR; PG8_SCHED;
            PG8_LDB(B1, 0, 1); PG8_STAGE(PG8_SB(0, 0), b2, voffB);
            PG8_BAR; PG8_WAIT_L(0); PG8_MMA(0, 1, At, B1); PG8_BAR;
            PG8_LDA(At, 0, 1); PG8_STAGE(PG8_SA(0, 0), a2, voffA);
            PG8_BAR; PG8_WAIT_L(0); PG8_MMA(1, 0, At, B0); PG8_BAR; PG8_SCHED;
            PG8_STAGE(PG8_SB(0, 1), b2 + hstepB, voffB);
            PG8_WAIT_V(6); PG8_BAR; PG8_MMA(1, 1, At, B1); PG8_BAR;
            PG8_LDB(B0, 1, 0); PG8_SCHED; PG8_LDA(At, 1, 0); PG8_STAGE(PG8_SA(0, 1), a2 + hstepA, voffA);
            PG8_WAIT_L(8); PG8_BAR; PG8_WAIT_L(0); PG8_MMA(0, 0, At, B0); PG8_BAR; PG8_SCHED;
            PG8_LDB(B1, 1, 1); PG8_STAGE(PG8_SB(1, 0), b3, voffB);
            PG8_BAR; PG8_WAIT_L(0); PG8_MMA(0, 1, At, B1); PG8_BAR;
            PG8_LDA(At, 1, 1); PG8_STAGE(PG8_SA(1, 0), a3, voffA);
            PG8_BAR; PG8_WAIT_L(0); PG8_MMA(1, 0, At, B0); PG8_BAR; PG8_SCHED;
            PG8_STAGE(PG8_SB(1, 1), b3 + hstepB, voffB);
            PG8_WAIT_V(6); PG8_BAR; PG8_MMA(1, 1, At, B1); PG8_BAR;
            }
        }
        if constexpr (ALIGN_EPI) { if (wr == 0) PG8_BAR; }
        if constexpr (!Epi::AFTER_DRAIN) { E(acc, cur, wr, wc, fr, fq); S.done(cur); }
        if (!has_next) break;
#pragma unroll
        for (int a = 0; a < 2; ++a)
#pragma unroll
            for (int b = 0; b < 2; ++b)
#pragma unroll
                for (int m = 0; m < 4; ++m)
#pragma unroll
                    for (int n = 0; n < 2; ++n) acc[a][b][m][n] = (f32x4){0.f, 0.f, 0.f, 0.f};
        cur = nxt; cA = nA; cB = nB; ++ui;
        if constexpr (ALIGN_EPI) { if (wr == 1) PG8_BAR; }
    }
    PG8_WAIT_V(0);
    if constexpr (!ALIGN_EPI) { if (wr == 0) PG8_BAR; }
    PG8_BAR;
    if constexpr (Epi::AFTER_DRAIN) { E.fused(acc, cur, wr, wc, fr, fq, lds, wid, lane); S.done(cur); }
#undef PG8_SA
#undef PG8_SB
#undef PG8_STAGE
#undef PG8_LDA
#undef PG8_LDB
#undef PG8_MMA
#undef PG8_WAIT_V
#undef PG8_WAIT_L
#undef PG8_BAR
#undef PG8_SCHED
}
}

#define LAS __attribute__((address_space(3)))
typedef unsigned short bf16_t;
typedef short bf16x8 __attribute__((ext_vector_type(8)));
typedef float f32x4 __attribute__((ext_vector_type(4)));
typedef float f32x16 __attribute__((ext_vector_type(16)));
typedef unsigned u32x4 __attribute__((ext_vector_type(4)));
typedef unsigned u32x2 __attribute__((ext_vector_type(2)));
typedef float f32x2_t __attribute__((ext_vector_type(2)));
typedef __bf16 bf16x2_t __attribute__((ext_vector_type(2)));

constexpr int MP = 65536, MS = 512, MT = MP + MS;
constexpr int TP = 4096, TS = 16, PAST = 4096;
constexpr int KVSEQ = PAST + TS;
constexpr int MKV = MP + 32 * KVSEQ;
constexpr int VT_LD = MKV + 64;
constexpr int NZ = 4352, ZW = 1280, QL = 768;
constexpr int IN_W = 4128;
constexpr float RMS_EPS = 1e-6f, LN_EPS = 1e-5f;
constexpr float C2 = 0.10206207261596577f * 1.4426950408889634f;

constexpr size_t OUT_Y = 0, OUT_LATP = (size_t)MT * 1024, OUT_KRP = OUT_LATP + (size_t)MP * 256, OUT_CVP = OUT_KRP + (size_t)MP * 32,
                 OUT_LATS = OUT_CVP + 16 * 30 * 512, OUT_KRS = OUT_LATS + (size_t)MS * 256, OUT_CVS = OUT_KRS + (size_t)MS * 32;

constexpr size_t al256(size_t x) { return (x + 255) & ~(size_t)255; }
constexpr size_t WS_ROPE = 0;
constexpr size_t WS_WIN = al256(WS_ROPE + (size_t)KVSEQ * 16 * 8);
constexpr size_t WS_WUQ = al256(WS_WIN + (size_t)NZ * 1024 * 2);
constexpr size_t WS_WUK = al256(WS_WUQ + (size_t)768 * QL * 2);
constexpr size_t WS_WUV = al256(WS_WUK + (size_t)512 * 256 * 2);
constexpr size_t WS_WAO = al256(WS_WUV + (size_t)512 * 256 * 2);
constexpr size_t WS_WCO = al256(WS_WAO + (size_t)1024 * 512 * 2);
constexpr size_t WS_WOUT = al256(WS_WCO + (size_t)1024 * 512 * 2);
constexpr size_t WS_WUP = al256(WS_WOUT + (size_t)1024 * 1024 * 2);
constexpr size_t WS_WDN = al256(WS_WUP + (size_t)4096 * 1024 * 2);
constexpr size_t WS_WPG = al256(WS_WDN + (size_t)4096 * 1024 * 2);
constexpr size_t WS_WPP = al256(WS_WPG + (size_t)1024 * 1024 * 2);
constexpr size_t WS_SLOT1 = al256(WS_WPP + (size_t)1024 * 256 * 2);
constexpr size_t WS_SLOT2 = al256(WS_SLOT1 + (size_t)MT * 16 * 4);
constexpr size_t WS_SLOT3 = al256(WS_SLOT2 + (size_t)MT * 16 * 4);
constexpr size_t WS_SLOTQ = al256(WS_SLOT3 + (size_t)MT * 16 * 4);
constexpr size_t WS_XN = al256(WS_SLOTQ + (size_t)MT * 16 * 4);
constexpr size_t WS_O = WS_XN;
constexpr size_t WS_CACT = al256(WS_O + (size_t)MT * 512 * 2);
constexpr size_t WS_R = al256(WS_XN + (size_t)MT * 1024 * 2);
constexpr size_t WS_ZS = WS_R, WS_M1 = WS_R, WS_H = WS_R;
constexpr size_t WS_U = al256(WS_ZS + (size_t)MT * ZW * 2);
constexpr size_t WS_VT = WS_U;
constexpr size_t WS_LATKV = al256(WS_VT + (size_t)512 * VT_LD * 2);
constexpr size_t WS_KB = al256(WS_LATKV + (size_t)(MKV + 64) * 256 * 2);
constexpr size_t WS_QB = al256(WS_KB + (size_t)(MKV + 64) * 768 * 2);
constexpr size_t WS_END1 = al256(WS_QB + (size_t)MT * 768 * 2);
constexpr size_t WS_PP = al256(WS_H + (size_t)MT * 4096 * 2);
constexpr size_t WS_PBF = al256(WS_PP + (size_t)MT * 1024 * 2);
constexpr size_t WS_END2 = al256(WS_PBF + (size_t)MT * 256 * 2);
static_assert(WS_END1 <= ((size_t)1 << 30) && WS_END2 <= ((size_t)1 << 30), "workspace map exceeds 1 GiB");
static_assert(WS_CACT + (size_t)MT * 512 * 2 <= WS_R, "O|CACT overlay");
static_assert(WS_U + (size_t)MT * 512 * 2 <= WS_LATKV, "U under V^T");
static_assert(WS_M1 + (size_t)MT * 1024 * 2 <= WS_KB, "M1 overlay");
static_assert(WS_PBF >= WS_M1 + (size_t)MT * 1024 * 2 && WS_PBF >= WS_KB && WS_END2 <= WS_QB, "PBF / PP placement inside the dead K buffer");
constexpr size_t WS_BAR = ((size_t)1 << 30) - 65536;
static_assert(WS_END1 <= WS_BAR && WS_END2 <= WS_BAR, "barrier words");
constexpr int LDS_BYTES = 131072 + 1024;

struct Params { const float* in[28]; float* out; unsigned char* ws; int ph_lo, ph_hi; };

__device__ __forceinline__ unsigned pk2(float lo, float hi) { f32x2_t v = {lo, hi}; bf16x2_t b = __builtin_convertvector(v, bf16x2_t); return __builtin_bit_cast(unsigned, b); }
__device__ __forceinline__ float bflo(unsigned w) { return __uint_as_float(w << 16); }
__device__ __forceinline__ float bfhi(unsigned w) { return __uint_as_float(w & 0xffff0000u); }
__device__ __forceinline__ float sigmoidf_(float x) { return __builtin_amdgcn_rcpf(1.0f + __expf(-x)); }
__device__ __forceinline__ float wave_sum(float v) {
#pragma unroll
    for (int o = 1; o < 64; o <<= 1) v += __shfl_xor(v, o);
    return v;
}
__device__ __forceinline__ f32x4 ld_nt(const float* p) { return __builtin_nontemporal_load((const f32x4*)p); }
__device__ __forceinline__ u32x4 pack8(const f32x4 a, const f32x4 b) { u32x4 w; w.x = pk2(a[0], a[1]); w.y = pk2(a[2], a[3]); w.z = pk2(b[0], b[1]); w.w = pk2(b[2], b[3]); return w; }
__device__ __forceinline__ void unpack8(const u32x4 w, f32x4& a, f32x4& b) { a = (f32x4){bflo(w.x), bfhi(w.x), bflo(w.y), bfhi(w.y)}; b = (f32x4){bflo(w.z), bfhi(w.z), bflo(w.w), bfhi(w.w)}; }
__device__ __forceinline__ float rs_from_slots(const float* s, float inv_n, float eps) {
    const f32x4 a = *(const f32x4*)s, b = *(const f32x4*)(s + 4), c = *(const f32x4*)(s + 8), d = *(const f32x4*)(s + 12);
    const float t = ((a[0] + a[1]) + (a[2] + a[3])) + ((b[0] + b[1]) + (b[2] + b[3])) + ((c[0] + c[1]) + (c[2] + c[3])) + ((d[0] + d[1]) + (d[2] + d[3]));
    return 1.0f / sqrtf(t * inv_n + eps);
}
__device__ __forceinline__ int pos_of_row(int row) { return row < MP ? (row & (TP - 1)) : PAST + ((row - MP) & (TS - 1)); }
__device__ __forceinline__ int kvrow_of_row(int row) { return row < MP ? row : MP + ((row - MP) >> 4) * KVSEQ + PAST + ((row - MP) & (TS - 1)); }

typedef pg8::Unit Unit;
#define EPI_ARGS const f32x4 (&acc)[2][2][4][2], const Unit& u, int wr, int wc, int fr, int fq
#define FOR_AI_M _Pragma("unroll") for (int ai = 0; ai < 2; ++ai) _Pragma("unroll") for (int m = 0; m < 4; ++m)
#define MEMFENCE asm volatile("" ::: "memory")

struct EpiIn {
    static constexpr bool PERM = true, AFTER_DRAIN = false;
    bf16_t* Zs; bf16_t* U; bf16_t* G; float* slotq;
    __device__ __forceinline__ void operator()(EPI_ARGS) const {
        const int pn = u.pn, cw = wc * 32 + 8 * fq;
        FOR_AI_M {
            const size_t row = (size_t)(u.pm * 256 + ai * 128 + wr * 64 + m * 16 + fr);
            if (pn < 5) {
#pragma unroll
                for (int bj = 0; bj < 2; ++bj) *(u32x4*)(Zs + row * ZW + pn * 256 + bj * 128 + cw) = pack8(acc[ai][bj][m][0], acc[ai][bj][m][1]);
                if (pn < 3) {
                    float ss = 0.f;
#pragma unroll
                    for (int bj = 0; bj < 2; ++bj)
#pragma unroll
                        for (int n = 0; n < 2; ++n) { const f32x4 v = acc[ai][bj][m][n]; ss += (v[0] * v[0] + v[1] * v[1]) + (v[2] * v[2] + v[3] * v[3]); }
                    ss += __shfl_xor(ss, 16); ss += __shfl_xor(ss, 32);
                    if (fq == 0) slotq[row * 16 + pn * 4 + wc] = ss;
                }
            } else if (pn < 9) {
                f32x4 v0, v1;
#pragma unroll
                for (int k = 0; k < 4; ++k) { v0[k] = acc[ai][0][m][0][k] * sigmoidf_(acc[ai][1][m][0][k]); v1[k] = acc[ai][0][m][1][k] * sigmoidf_(acc[ai][1][m][1][k]); }
                *(u32x4*)(U + row * 512 + (pn - 5) * 128 + cw) = pack8(v0, v1);
            } else {
#pragma unroll
                for (int bj = 0; bj < 2; ++bj) { f32x4 v0, v1;
#pragma unroll
                    for (int k = 0; k < 4; ++k) { v0[k] = sigmoidf_(acc[ai][bj][m][0][k]); v1[k] = sigmoidf_(acc[ai][bj][m][1][k]); }
                    *(u32x4*)(G + row * 2048 + (pn - 9) * 256 + bj * 128 + cw) = pack8(v0, v1); }
            }
        }
    }
};
struct EpiQ {
    static constexpr bool PERM = false, AFTER_DRAIN = false;
    bf16_t* QB; const float* rope; const float* slotq;
    __device__ __forceinline__ void operator()(EPI_ARGS) const {
#pragma unroll
        for (int bj = 0; bj < 2; ++bj) {
            const int c0 = u.pn * 256 + bj * 128 + wc * 32;
            const bool isrope = (c0 % 96) == 64;
            FOR_AI_M {
                const int row = u.pm * 256 + ai * 128 + wr * 64 + m * 16 + fr;
                bf16_t* dst = QB + (size_t)row * 768 + c0 + 4 * fq;
                const float* sq = slotq + (size_t)row * 16;
                const f32x4 s0 = *(const f32x4*)sq, s1 = *(const f32x4*)(sq + 4), s2 = *(const f32x4*)(sq + 8);
                const float rq = 1.0f / sqrtf((((s0[0] + s0[1]) + (s0[2] + s0[3])) + ((s1[0] + s1[1]) + (s1[2] + s1[3])) + ((s2[0] + s2[1]) + (s2[2] + s2[3]))) * (1.0f / (float)QL) + RMS_EPS);
                f32x4 a = acc[ai][bj][m][0] * rq, b = acc[ai][bj][m][1] * rq;
                if (isrope) {
                    const float* cs = rope + ((size_t)pos_of_row(row) * 16 + 4 * fq) * 2;
                    const f32x4 t0 = *(const f32x4*)cs, t1 = *(const f32x4*)(cs + 4);
                    const f32x4 c = {t0[0], t0[2], t1[0], t1[2]}, s = {t0[1], t0[3], t1[1], t1[3]};
                    const f32x4 o1 = a * c - b * s, o2 = b * c + a * s; a = o1; b = o2;
                }
                a = a * C2; b = b * C2;
                u32x2 w0, w1; w0.x = pk2(a[0], a[1]); w0.y = pk2(a[2], a[3]); w1.x = pk2(b[0], b[1]); w1.y = pk2(b[2], b[3]);
                *(u32x2*)dst = w0; *(u32x2*)(dst + 16) = w1;
                MEMFENCE;
            }
        }
    }
};
struct EpiK {
    static constexpr bool PERM = true, AFTER_DRAIN = false;
    bf16_t* KB;
    __device__ __forceinline__ void operator()(EPI_ARGS) const {
        FOR_AI_M {
            const size_t row = (size_t)(u.pm * 256 + ai * 128 + wr * 64 + m * 16 + fr);
#pragma unroll
            for (int bj = 0; bj < 2; ++bj) { const int c = u.pn * 256 + bj * 128 + wc * 32 + 8 * fq; *(u32x4*)(KB + row * 768 + (c >> 6) * 96 + (c & 63)) = pack8(acc[ai][bj][m][0], acc[ai][bj][m][1]); }
        }
    }
};
struct EpiStore {
    static constexpr bool PERM = true, AFTER_DRAIN = false;
    bf16_t* O; size_t ldc;
    __device__ __forceinline__ void operator()(EPI_ARGS) const {
        FOR_AI_M {
            const size_t row = (size_t)(u.pm * 256 + ai * 128 + wr * 64 + m * 16 + fr);
#pragma unroll
            for (int bj = 0; bj < 2; ++bj) { const int c = u.pn * 256 + bj * 128 + wc * 32 + 8 * fq; *(u32x4*)(O + row * ldc + c) = pack8(acc[ai][bj][m][0], acc[ai][bj][m][1]); }
        }
    }
};
template <bool ACCUM> struct EpiGate {
    static constexpr bool PERM = true, AFTER_DRAIN = false;
    bf16_t* M1; const bf16_t* G; int goff;
    __device__ __forceinline__ void operator()(EPI_ARGS) const {
        FOR_AI_M {
            const size_t row = (size_t)(u.pm * 256 + ai * 128 + wr * 64 + m * 16 + fr);
#pragma unroll
            for (int bj = 0; bj < 2; ++bj) { const int c = u.pn * 256 + bj * 128 + wc * 32 + 8 * fq;
                f32x4 g0, g1; unpack8(*(const u32x4*)(G + row * 2048 + goff + c), g0, g1);
                f32x4 v0 = acc[ai][bj][m][0] * g0, v1 = acc[ai][bj][m][1] * g1;
                if (ACCUM) { f32x4 o0, o1; unpack8(*(const u32x4*)(M1 + row * 1024 + c), o0, o1); v0 = v0 + o0; v1 = v1 + o1; }
                *(u32x4*)(M1 + row * 1024 + c) = pack8(v0, v1); }
            if (m & 1) MEMFENCE;
        }
    }
};
struct EpiRes {
    static constexpr bool PERM = true, AFTER_DRAIN = false;
    const float* base_p; const float* base_s; float* X; bf16_t* XB; float* slots;
    __device__ __forceinline__ void operator()(EPI_ARGS) const {
        FOR_AI_M {
            const int row = u.pm * 256 + ai * 128 + wr * 64 + m * 16 + fr;
            const float* bs = row < MP ? base_p + (size_t)row * 1024 : base_s + (size_t)(row - MP) * 1024;
            float ss = 0.f;
#pragma unroll
            for (int bj = 0; bj < 2; ++bj) { const int c = u.pn * 256 + bj * 128 + wc * 32 + 8 * fq;
                const f32x4 v0 = acc[ai][bj][m][0] + *(const f32x4*)(bs + c), v1 = acc[ai][bj][m][1] + *(const f32x4*)(bs + c + 4);
                *(f32x4*)(X + (size_t)row * 1024 + c) = v0; *(f32x4*)(X + (size_t)row * 1024 + c + 4) = v1;
                *(u32x4*)(XB + (size_t)row * 1024 + c) = pack8(v0, v1);
                ss += (v0[0] * v0[0] + v0[1] * v0[1]) + (v0[2] * v0[2] + v0[3] * v0[3]) + (v1[0] * v1[0] + v1[1] * v1[1]) + (v1[2] * v1[2] + v1[3] * v1[3]); }
            ss += __shfl_xor(ss, 16); ss += __shfl_xor(ss, 32);
            if (fq == 0) slots[(size_t)row * 16 + u.pn * 4 + wc] = ss;
            if (m & 1) MEMFENCE;
        }
    }
};
struct EpiUp {
    static constexpr bool PERM = true, AFTER_DRAIN = false;
    bf16_t* H; const float* slots;
    __device__ __forceinline__ void operator()(EPI_ARGS) const {
        FOR_AI_M {
            const size_t row = (size_t)(u.pm * 256 + ai * 128 + wr * 64 + m * 16 + fr);
            const float rs = rs_from_slots(slots + row * 16, 1.0f / 1024.0f, RMS_EPS);
#pragma unroll
            for (int bj = 0; bj < 2; ++bj) { const int c = u.pn * 256 + bj * 128 + wc * 32 + 8 * fq;
                f32x4 v0 = acc[ai][bj][m][0] * rs, v1 = acc[ai][bj][m][1] * rs;
#pragma unroll
                for (int k = 0; k < 4; ++k) { const float a = fmaxf(v0[k], 0.f), b = fmaxf(v1[k], 0.f); v0[k] = a * a; v1[k] = b * b; }
                *(u32x4*)(H + row * 4096 + c) = pack8(v0, v1); }
            if (m & 1) MEMFENCE;
        }
    }
};
struct EpiPle {
    static constexpr bool PERM = true, AFTER_DRAIN = false;
    float* X; const bf16_t* PP; const float* slots2; float* slots3;
    __device__ __forceinline__ void operator()(EPI_ARGS) const {
        FOR_AI_M {
            const size_t row = (size_t)(u.pm * 256 + ai * 128 + wr * 64 + m * 16 + fr);
            const float rs = rs_from_slots(slots2 + row * 16, 1.0f / 1024.0f, RMS_EPS);
            float ss = 0.f;
#pragma unroll
            for (int bj = 0; bj < 2; ++bj) { const int c = u.pn * 256 + bj * 128 + wc * 32 + 8 * fq;
                f32x4 p0, p1; unpack8(*(const u32x4*)(PP + row * 1024 + c), p0, p1);
                f32x4 v0 = *(const f32x4*)(X + row * 1024 + c), v1 = *(const f32x4*)(X + row * 1024 + c + 4);
#pragma unroll
                for (int k = 0; k < 4; ++k) { v0[k] += sigmoidf_(acc[ai][bj][m][0][k] * rs) * p0[k]; v1[k] += sigmoidf_(acc[ai][bj][m][1][k] * rs) * p1[k]; }
                *(f32x4*)(X + row * 1024 + c) = v0; *(f32x4*)(X + row * 1024 + c + 4) = v1;
                ss += (v0[0] * v0[0] + v0[1] * v0[1]) + (v0[2] * v0[2] + v0[3] * v0[3]) + (v1[0] * v1[0] + v1[1] * v1[1]) + (v1[2] * v1[2] + v1[3] * v1[3]); }
            ss += __shfl_xor(ss, 16); ss += __shfl_xor(ss, 32);
            if (fq == 0) slots3[row * 16 + u.pn * 4 + wc] = ss;
            MEMFENCE;
        }
    }
};

struct EpiAtomic {
    static constexpr bool PERM = true, AFTER_DRAIN = false;
    float* X;
    __device__ __forceinline__ void operator()(EPI_ARGS) const {
        FOR_AI_M {
            const size_t row = (size_t)(u.pm * 256 + ai * 128 + wr * 64 + m * 16 + fr);
#pragma unroll
            for (int bj = 0; bj < 2; ++bj) { const int c = u.pn * 256 + bj * 128 + wc * 32 + 8 * fq; float* d = X + row * 1024 + c;
#pragma unroll
                for (int k = 0; k < 4; ++k) { (void)__hip_atomic_fetch_add(d + k, acc[ai][bj][m][0][k], __ATOMIC_RELAXED, __HIP_MEMORY_SCOPE_AGENT); (void)__hip_atomic_fetch_add(d + 4 + k, acc[ai][bj][m][1][k], __ATOMIC_RELAXED, __HIP_MEMORY_SCOPE_AGENT); } }
        }
    }
};
struct OneUnit {
    int pm, pn;
    __device__ __forceinline__ bool next(int i, Unit& u) const { if (i != 0) return false; u.pm = pm; u.pn = pn; return true; }
    __device__ __forceinline__ void a_ready(const Unit&) const {}
    __device__ __forceinline__ void done(const Unit&) const {}
};
__device__ __forceinline__ void phase_sample_post(const Params& p) {
    const int lane = threadIdx.x & 63, gw = blockIdx.x * 8 + (threadIdx.x >> 6), NGW = gridDim.x * 8;
    bf16_t* XB = (bf16_t*)(p.ws + WS_XN); float* slots = (float*)(p.ws + WS_SLOT2);
    for (int r = gw; r < MS; r += NGW) {
        const size_t row = (size_t)MP + r; const float* x = p.out + OUT_Y + row * 1024; float s = 0.f;
#pragma unroll
        for (int j = 0; j < 4; ++j) { const f32x4 v = *(const f32x4*)(x + 4 * lane + 256 * j); s += (v[0] * v[0] + v[1] * v[1]) + (v[2] * v[2] + v[3] * v[3]);
            u32x2 w; w.x = pk2(v[0], v[1]); w.y = pk2(v[2], v[3]); *(u32x2*)(XB + row * 1024 + 4 * lane + 256 * j) = w; }
        s = wave_sum(s);
        if (lane < 16) slots[row * 16 + lane] = lane == 0 ? s : 0.f;
    }
}
template <class Epi> __device__ __forceinline__ void run_gemm(LAS unsigned char* lds, const bf16_t* A, const bf16_t* Bt, int M, int N, int K, const Epi& E, int rot = 0, int lda = 0) {
    asm volatile("" : "+s"(K));
    pg8::Gemm g{A, Bt, M, N, K, lda ? lda : K, K}; pg8::StaticOrder S; S.init(M, N, (int)gridDim.x, (int)((blockIdx.x + rot) % gridDim.x));
    pg8::gemm_phase<Epi, pg8::StaticOrder, true, true>(lds, g, S, E);
}

__device__ __forceinline__ void tr_item(const float* W, int ldw, int K, bf16_t* WT, int src_c0, int dst_r0, int k0, const float* ksc, LAS float* scr, int lane) {
    float tv[32];
#pragma unroll
    for (int i = 0; i < 32; ++i) { const int kk = 2 * i + (lane >> 5); tv[i] = 0.f;
        if (src_c0 >= 0) { tv[i] = W[(size_t)(k0 + kk) * ldw + src_c0 + (lane & 31)]; if (ksc) tv[i] *= ksc[k0 + kk]; } }
#pragma unroll
    for (int i = 0; i < 32; ++i) { const int kk = 2 * i + (lane >> 5); scr[kk * 33 + (lane & 31)] = tv[i]; }
    asm volatile("s_waitcnt lgkmcnt(0)" ::: "memory");
    const int c = lane & 7;
#pragma unroll
    for (int j = 0; j < 4; ++j) { const int n = (lane >> 3) + 8 * j; const LAS float* s = scr + (8 * c) * 33 + n;
        u32x4 o; o.x = pk2(s[0 * 33], s[1 * 33]); o.y = pk2(s[2 * 33], s[3 * 33]); o.z = pk2(s[4 * 33], s[5 * 33]); o.w = pk2(s[6 * 33], s[7 * 33]);
        *(u32x4*)(WT + (size_t)(dst_r0 + n) * K + k0 + 8 * c) = o; }
    asm volatile("s_waitcnt lgkmcnt(0)" ::: "memory");
}
__device__ __forceinline__ int win_src_col(int n) {
    if (n < 1056) return n;
    if (n < 1280) return -1;
    if (n < 2304) { const int q = n - 1280, i = q >> 8, j = q & 255; return j < 128 ? 1056 + 128 * i + j : 1056 + 512 + 128 * i + (j - 128); }
    return 2080 + (n - 2304);
}
__device__ __forceinline__ bool tr_mat(int& r, const float* W, int K, int N, bf16_t* WT, const float* ksc, LAS float* scr, int lane) {
    const int nblk = N / 32, items = (K / 64) * nblk;
    if (r >= items) { r -= items; return false; }
    const int kb = r / nblk, nb = r % nblk;
    tr_item(W, N, K, WT, 32 * nb, 32 * nb, 64 * kb, ksc, scr, lane);
    return true;
}
constexpr int W_I_WIN = 16 * (NZ / 32);
constexpr int W_ITEMS_EARLY = W_I_WIN + 12 * 24 + 4 * 16 * 2 + 8 * 32 * 2 + 16 * 32;
constexpr int W_ITEMS_UP = W_ITEMS_EARLY + 16 * 128;
constexpr int W_ITEMS_ALL = W_ITEMS_UP + 64 * 32 + 16 * 32 + 4 * 32;
__device__ __forceinline__ void tr_range(const Params& p, LAS unsigned char* lds, int lo, int hi, int vb, int vg) {
    const int tid = threadIdx.x, lane = tid & 63, wave = tid >> 6;
    const int gw = vb * 8 + wave, NGW = vg * 8;
    unsigned char* ws = p.ws;
    LAS float* scr = (LAS float*)(lds + wave * 16384);
    constexpr int I_WIN = W_I_WIN;
    for (int it = lo + gw; it < hi; it += NGW) {
        int r = it;
        if (r < I_WIN) { const int nblk = NZ / 32, kb = r / nblk, nb = r % nblk; tr_item(p.in[8], IN_W, 1024, (bf16_t*)(ws + WS_WIN), win_src_col(32 * nb), 32 * nb, 64 * kb, nullptr, scr, lane); continue; }
        r -= I_WIN;
        if (tr_mat(r, p.in[10], QL, 768, (bf16_t*)(ws + WS_WUQ), p.in[9], scr, lane)) continue;
        if (tr_mat(r, p.in[12], 256, 512, (bf16_t*)(ws + WS_WUK), nullptr, scr, lane)) continue;
        if (tr_mat(r, p.in[13], 256, 512, (bf16_t*)(ws + WS_WUV), nullptr, scr, lane)) continue;
        if (tr_mat(r, p.in[14], 512, 1024, (bf16_t*)(ws + WS_WAO), nullptr, scr, lane)) continue;
        if (tr_mat(r, p.in[19], 512, 1024, (bf16_t*)(ws + WS_WCO), nullptr, scr, lane)) continue;
        if (tr_mat(r, p.in[20], 1024, 1024, (bf16_t*)(ws + WS_WOUT), nullptr, scr, lane)) continue;
        if (tr_mat(r, p.in[22], 1024, 4096, (bf16_t*)(ws + WS_WUP), p.in[21], scr, lane)) continue;
        if (tr_mat(r, p.in[23], 4096, 1024, (bf16_t*)(ws + WS_WDN), nullptr, scr, lane)) continue;
        if (tr_mat(r, p.in[25], 1024, 1024, (bf16_t*)(ws + WS_WPG), p.in[24], scr, lane)) continue;
        tr_mat(r, p.in[26], 256, 1024, (bf16_t*)(ws + WS_WPP), nullptr, scr, lane);
    }
}
__device__ __forceinline__ void phase0(const Params& p, LAS unsigned char* lds) {
    const int tid = threadIdx.x, lane = tid & 63, wave = tid >> 6;
    const int gw = blockIdx.x * 8 + wave, NGW = gridDim.x * 8;
    const size_t gt = (size_t)blockIdx.x * 512 + tid, NGT = (size_t)gridDim.x * 512;
    unsigned char* ws = p.ws;
    LAS float* scr = (LAS float*)(lds + wave * 16384);
    tr_range(p, lds, 0, W_ITEMS_EARLY, (int)blockIdx.x, (int)gridDim.x);
    {
        const float* g = p.in[7]; bf16_t* XN = (bf16_t*)(ws + WS_XN);
        f32x4 gv[4];
#pragma unroll
        for (int j = 0; j < 4; ++j) gv[j] = *(const f32x4*)(g + 4 * lane + 256 * j);
        for (int row = gw; row < MT; row += 2 * NGW) {
            const int rowb = row + NGW; const bool vb = rowb < MT; const int rb = vb ? rowb : row;
            const float* xr = row < MP ? p.in[0] + (size_t)row * 1024 : p.in[1] + (size_t)(row - MP) * 1024;
            const float* xq = rb < MP ? p.in[0] + (size_t)rb * 1024 : p.in[1] + (size_t)(rb - MP) * 1024;
            f32x4 v[4], u[4]; float s = 0.f, t = 0.f;
#pragma unroll
            for (int j = 0; j < 4; ++j) { v[j] = ld_nt(xr + 4 * lane + 256 * j); u[j] = ld_nt(xq + 4 * lane + 256 * j); }
#pragma unroll
            for (int j = 0; j < 4; ++j) { s += (v[j][0] * v[j][0] + v[j][1] * v[j][1]) + (v[j][2] * v[j][2] + v[j][3] * v[j][3]); t += (u[j][0] * u[j][0] + u[j][1] * u[j][1]) + (u[j][2] * u[j][2] + u[j][3] * u[j][3]); }
            const float rs = 1.0f / sqrtf(wave_sum(s) * (1.0f / 1024.0f) + RMS_EPS), rt = 1.0f / sqrtf(wave_sum(t) * (1.0f / 1024.0f) + RMS_EPS);
#pragma unroll
            for (int j = 0; j < 4; ++j) { const f32x4 o = v[j] * rs * gv[j]; u32x2 w; w.x = pk2(o[0], o[1]); w.y = pk2(o[2], o[3]); *(u32x2*)(XN + (size_t)row * 1024 + 4 * lane + 256 * j) = w; }
            if (vb) {
#pragma unroll
                for (int j = 0; j < 4; ++j) { const f32x4 o = u[j] * rt * gv[j]; u32x2 w; w.x = pk2(o[0], o[1]); w.y = pk2(o[2], o[3]); *(u32x2*)(XN + (size_t)rowb * 1024 + 4 * lane + 256 * j) = w; }
            }
        }
    }
    {
        float* R = (float*)(ws + WS_ROPE);
        for (size_t e = gt; e < (size_t)KVSEQ * 16; e += NGT) {
            const int pos = (int)(e >> 4), i = (int)(e & 15);
            const float inv = exp2f(-(float)i * (13.287712379549449f / 16.0f));
            const float ang = (float)pos * inv;
            R[2 * e] = cosf(ang); R[2 * e + 1] = sinf(ang);
        }
    }
}

__device__ __forceinline__ void phase_cache(const Params& p, int vb, int vg) {
    const size_t gt = (size_t)vb * 512 + threadIdx.x, NGT = (size_t)vg * 512;
    unsigned char* ws = p.ws;
    {
        const float* src = p.in[4]; bf16_t* L = (bf16_t*)(ws + WS_LATKV);
        for (size_t e0 = gt; e0 < (size_t)32 * PAST * 32; e0 += 4 * NGT) {
            f32x4 a[4], bb[4];
#pragma unroll
            for (int i = 0; i < 4; ++i) { const size_t e = e0 + i * NGT; if (e < (size_t)32 * PAST * 32) { a[i] = ld_nt(src + e * 8); bb[i] = ld_nt(src + e * 8 + 4); } }
#pragma unroll
            for (int i = 0; i < 4; ++i) { const size_t e = e0 + i * NGT; if (e < (size_t)32 * PAST * 32) {
                const size_t row = e >> 5; const int c8 = (int)(e & 31); const int b = (int)(row >> 12), k = (int)(row & 4095);
                *(u32x4*)(L + (size_t)(MP + b * KVSEQ + k) * 256 + c8 * 8) = pack8(a[i], bb[i]); } }
        }
    }
    {
        const float* src = p.in[5]; bf16_t* KB = (bf16_t*)(ws + WS_KB);
        for (size_t e = gt; e < (size_t)32 * PAST * 4; e += NGT) {
            const size_t row = e >> 2; const int c8 = (int)(e & 3); const int b = (int)(row >> 12), k = (int)(row & 4095);
            const f32x4 a = ld_nt(src + row * 32 + c8 * 8), bb = ld_nt(src + row * 32 + c8 * 8 + 4);
            const u32x4 w = pack8(a, bb); bf16_t* d = KB + (size_t)(MP + b * KVSEQ + k) * 768 + 64 + c8 * 8;
#pragma unroll
            for (int h = 0; h < 8; ++h) *(u32x4*)(d + h * 96) = w;
        }
    }
}
__device__ __forceinline__ void phase_pbf(const Params& p, int vb, int vg) {
    const size_t gt = (size_t)vb * 512 + threadIdx.x, NGT = (size_t)vg * 512;
    bf16_t* P = (bf16_t*)(p.ws + WS_PBF);
    for (size_t e = gt; e < (size_t)MT * 32; e += NGT) {
        const float* s = e < (size_t)MP * 32 ? p.in[2] + e * 8 : p.in[3] + (e - (size_t)MP * 32) * 8;
        *(u32x4*)(P + e * 8) = pack8(ld_nt(s), ld_nt(s + 4));
    }
}
struct TokIn { u32x4 kv, kr; f32x4 t0, t1, t2, t3; };
__device__ __forceinline__ TokIn tok_load(const bf16_t* Zs, const float* rope, int row, int lane) {
    TokIn r; const bf16_t* z = Zs + (size_t)row * ZW;
    r.kv = (u32x4){0u, 0u, 0u, 0u}; r.kr = r.kv; r.t0 = (f32x4){0.f, 0.f, 0.f, 0.f}; r.t1 = r.t0; r.t2 = r.t0; r.t3 = r.t0;
    if (lane < 32) r.kv = *(const u32x4*)(z + 768 + 8 * lane);
    if (lane < 4) { r.kr = *(const u32x4*)(z + 1024 + 8 * lane);
        const float* cs = rope + ((size_t)pos_of_row(row) * 16 + 8 * (lane & 1)) * 2;
        r.t0 = *(const f32x4*)cs; r.t1 = *(const f32x4*)(cs + 4); r.t2 = *(const f32x4*)(cs + 8); r.t3 = *(const f32x4*)(cs + 12); }
    return r;
}
__device__ __forceinline__ void tok_proc(const Params& p, const TokIn& in, int row, int lane, bf16_t* L, bf16_t* KB, const f32x4& kg0, const f32x4& kg1) {
    const int kvrow = kvrow_of_row(row);
    f32x4 b0, b1; unpack8(in.kv, b0, b1);
    const float s = (b0[0] * b0[0] + b0[1] * b0[1]) + (b0[2] * b0[2] + b0[3] * b0[3]) + (b1[0] * b1[0] + b1[1] * b1[1]) + (b1[2] * b1[2] + b1[3] * b1[3]);
    const float rk = 1.0f / sqrtf(wave_sum(s) * (1.0f / 256.0f) + RMS_EPS);
    if (lane < 32) {
        const f32x4 l0 = b0 * rk * kg0, l1 = b1 * rk * kg1;
        float* o = row < MP ? p.out + OUT_LATP + (size_t)row * 256 : p.out + OUT_LATS + (size_t)(row - MP) * 256;
        *(f32x4*)(o + 8 * lane) = l0; *(f32x4*)(o + 8 * lane + 4) = l1;
        *(u32x4*)(L + (size_t)kvrow * 256 + 8 * lane) = pack8(l0, l1);
    }
    f32x4 c0, c1; unpack8(in.kr, c0, c1);
    f32x4 d0, d1;
#pragma unroll
    for (int k = 0; k < 4; ++k) { d0[k] = __shfl_xor(c0[k], 2); d1[k] = __shfl_xor(c1[k], 2); }
    if (lane < 4) {
        const f32x4 cc0 = {in.t0[0], in.t0[2], in.t1[0], in.t1[2]}, ss0 = {in.t0[1], in.t0[3], in.t1[1], in.t1[3]}, cc1 = {in.t2[0], in.t2[2], in.t3[0], in.t3[2]}, ss1 = {in.t2[1], in.t2[3], in.t3[1], in.t3[3]};
        f32x4 o0, o1;
        if (lane < 2) { o0 = c0 * cc0 - d0 * ss0; o1 = c1 * cc1 - d1 * ss1; }
        else { o0 = c0 * cc0 + d0 * ss0; o1 = c1 * cc1 + d1 * ss1; }
        float* o = row < MP ? p.out + OUT_KRP + (size_t)row * 32 : p.out + OUT_KRS + (size_t)(row - MP) * 32;
        *(f32x4*)(o + 8 * lane) = o0; *(f32x4*)(o + 8 * lane + 4) = o1;
        const u32x4 w = pack8(o0, o1); bf16_t* d = KB + (size_t)kvrow * 768 + 64 + 8 * lane;
#pragma unroll
        for (int h = 0; h < 8; ++h) *(u32x4*)(d + h * 96) = w;
    }
}
__device__ __forceinline__ void phase_mid_tokens(const Params& p) {
    const int tid = threadIdx.x, lane = tid & 63, wave = tid >> 6;
    const int gw = blockIdx.x * 8 + wave, NGW = gridDim.x * 8;
    unsigned char* ws = p.ws;
    const bf16_t* Zs = (const bf16_t*)(ws + WS_ZS); bf16_t* L = (bf16_t*)(ws + WS_LATKV); bf16_t* KB = (bf16_t*)(ws + WS_KB);
    const float* rope = (const float*)(ws + WS_ROPE);
    const float* kg = p.in[11];
    f32x4 kg0 = {1.f, 1.f, 1.f, 1.f}, kg1 = kg0;
    if (lane < 32) { kg0 = *(const f32x4*)(kg + 8 * lane); kg1 = *(const f32x4*)(kg + 8 * lane + 4); }
    for (int row = gw; row < MT; row += 4 * NGW) {
        const int r1 = row + NGW, r2 = row + 2 * NGW, r3 = row + 3 * NGW; const bool v1 = r1 < MT, v2 = r2 < MT, v3 = r3 < MT;
        const TokIn A = tok_load(Zs, rope, row, lane), B = tok_load(Zs, rope, v1 ? r1 : row, lane), C = tok_load(Zs, rope, v2 ? r2 : row, lane), D = tok_load(Zs, rope, v3 ? r3 : row, lane);
        tok_proc(p, A, row, lane, L, KB, kg0, kg1);
        if (v1) tok_proc(p, B, r1, lane, L, KB, kg0, kg1);
        if (v2) tok_proc(p, C, r2, lane, L, KB, kg0, kg1);
        if (v3) tok_proc(p, D, r3, lane, L, KB, kg0, kg1);
    }
}
__device__ __forceinline__ void phase_mid_conv(const Params& p, LAS unsigned char* lds) {
    const int tid = threadIdx.x, lane = tid & 63, wave = tid >> 6;
    unsigned char* ws = p.ws;
    const bf16_t* U = (const bf16_t*)(ws + WS_U); bf16_t* CACT = (bf16_t*)(ws + WS_CACT);
    LAS unsigned* ut = (LAS unsigned*)lds;
    LAS float* dwb = (LAS float*)(lds + 62 * 1024);
    const int cp = tid & 255, half = tid >> 8;
    f32x2_t w[31];
#pragma unroll
    for (int j = 0; j < 31; ++j) w[j] = *(const f32x2_t*)(p.in[15] + j * 512 + 2 * cp);
    const f32x2_t cb = *(const f32x2_t*)(p.in[16] + 2 * cp);
    const f32x4 lg0 = *(const f32x4*)(p.in[17] + 8 * lane), lg1 = *(const f32x4*)(p.in[17] + 8 * lane + 4), lb0 = *(const f32x4*)(p.in[18] + 8 * lane), lb1 = *(const f32x4*)(p.in[18] + 8 * lane + 4);
    constexpr int NBLK = MP / 32 + 32;
    u32x4 stg[8];
#define CONV_LOAD(cbk_) do { const int cbk__ = (cbk_); const bool pr_ = cbk__ < MP / 32; const int sb_ = cbk__ - MP / 32; \
        const int t0_ = pr_ ? (cbk__ & 127) * 32 : 0, R_ = pr_ ? 32 : 16, row0_ = pr_ ? cbk__ * 32 : MP + sb_ * 16; \
        _Pragma("unroll") for (int i_ = 0; i_ < 8; ++i_) { const int ch_ = tid + 512 * i_, rr_ = ch_ >> 6, c8_ = ch_ & 63, t_ = t0_ - 30 + rr_; \
            u32x4 w_ = {0u, 0u, 0u, 0u}; \
            if (rr_ < 30 + R_) { if (t_ >= 0) w_ = *(const u32x4*)(U + (size_t)(row0_ + rr_ - 30) * 512 + c8_ * 8); \
                else if (!pr_) { const float* hs_ = p.in[6] + ((size_t)sb_ * 30 + rr_) * 512 + c8_ * 8; w_ = pack8(*(const f32x4*)hs_, *(const f32x4*)(hs_ + 4)); } } \
            stg[i_] = w_; } } while (0)
    if ((int)blockIdx.x < NBLK) CONV_LOAD(blockIdx.x);
    for (int cbk = blockIdx.x; cbk < NBLK; cbk += gridDim.x) {
        const bool prompt = cbk < MP / 32;
        const int sb = cbk - MP / 32;
        const int R = prompt ? 32 : 16;
        const int row0 = prompt ? cbk * 32 : MP + sb * 16;
#pragma unroll
        for (int i = 0; i < 8; ++i) { const int ch = tid + 512 * i, rr = ch >> 6, c8 = ch & 63; if (rr < 62) *(LAS u32x4*)(ut + rr * 256 + c8 * 4) = stg[i]; }
        __syncthreads();
        if (cbk + (int)gridDim.x < NBLK) CONV_LOAD(cbk + gridDim.x);
        if (half * 16 < R) {
#pragma unroll 1
            for (int hh = 0; hh < 2; ++hh) {
                const int tb = half * 16 + hh * 8;
                f32x2_t uu[38];
#pragma unroll
                for (int r = 0; r < 38; ++r) { const unsigned x = ut[(tb + r) * 256 + cp]; uu[r] = (f32x2_t){bflo(x), bfhi(x)}; }
#pragma unroll
                for (int tt = 0; tt < 8; ++tt) {
                    f32x2_t a = cb;
#pragma unroll
                    for (int j = 0; j < 31; ++j) a = __builtin_elementwise_fma(w[j], uu[tt + j], a);
                    *(LAS f32x2_t*)(dwb + (tb + tt) * 512 + 2 * cp) = a;
                }
            }
        }
        __syncthreads();
#pragma unroll
        for (int i = 0; i < 4; ++i) {
            const int tl = wave * 4 + i;
            if (tl < R) {
                const f32x4 v0 = *(const LAS f32x4*)(dwb + tl * 512 + 8 * lane), v1 = *(const LAS f32x4*)(dwb + tl * 512 + 8 * lane + 4);
                const float mean = wave_sum((v0[0] + v0[1]) + (v0[2] + v0[3]) + (v1[0] + v1[1]) + (v1[2] + v1[3])) * (1.0f / 512.0f);
                const f32x4 e0 = v0 - mean, e1 = v1 - mean;
                const float var = wave_sum((e0[0] * e0[0] + e0[1] * e0[1]) + (e0[2] * e0[2] + e0[3] * e0[3]) + (e1[0] * e1[0] + e1[1] * e1[1]) + (e1[2] * e1[2] + e1[3] * e1[3])) * (1.0f / 512.0f);
                const float rstd = 1.0f / sqrtf(var + LN_EPS);
                f32x4 y0 = e0 * rstd * lg0 + lb0, y1 = e1 * rstd * lg1 + lb1;
#pragma unroll
                for (int k = 0; k < 4; ++k) { y0[k] = y0[k] * sigmoidf_(y0[k]); y1[k] = y1[k] * sigmoidf_(y1[k]); }
                *(u32x4*)(CACT + (size_t)(row0 + tl) * 512 + 8 * lane) = pack8(y0, y1);
            }
        }
        __syncthreads();
    }
#undef CONV_LOAD
    {
        const size_t gt = (size_t)blockIdx.x * 512 + tid, NGT = (size_t)gridDim.x * 512;
        for (size_t e = gt; e < (size_t)(16 + 32) * 30 * 512; e += NGT) {
            if (e < (size_t)16 * 30 * 512) { const int b = (int)(e / (30 * 512)), i = (int)((e / 512) % 30), c = (int)(e & 511);
                p.out[OUT_CVP + e] = __uint_as_float((unsigned)U[(size_t)(b * TP + TP - 30 + i) * 512 + c] << 16); }
            else { const size_t f = e - (size_t)16 * 30 * 512; const int sbb = (int)(f / (30 * 512)), i = (int)((f / 512) % 30), c = (int)(f & 511);
                p.out[OUT_CVS + f] = i < 14 ? p.in[6][((size_t)sbb * 30 + 16 + i) * 512 + c] : __uint_as_float((unsigned)U[(size_t)(MP + sbb * 16 + i - 14) * 512 + c] << 16); }
        }
    }
}

constexpr int AK_PITCH = 208, AV_PITCH = 136, AK_BYTES = 64 * AK_PITCH, AV_BYTES = 64 * AV_PITCH, AV_OFF = 2 * AK_BYTES;
constexpr float ATT_THR = 6.0f;
__device__ __forceinline__ float rowmax32(const f32x16& a, const f32x16& b) {
    float m0 = __builtin_fmaxf(__builtin_fmaxf(a[0], a[1]), b[0]), m1 = __builtin_fmaxf(__builtin_fmaxf(a[2], a[3]), b[1]);
    m0 = __builtin_fmaxf(__builtin_fmaxf(m0, b[2]), b[3]);
#pragma unroll
    for (int r = 4; r < 16; r += 4) { m0 = __builtin_fmaxf(__builtin_fmaxf(m0, a[r]), a[r + 1]); m1 = __builtin_fmaxf(__builtin_fmaxf(m1, a[r + 2]), a[r + 3]);
        m0 = __builtin_fmaxf(__builtin_fmaxf(m0, b[r]), b[r + 1]); m1 = __builtin_fmaxf(__builtin_fmaxf(m1, b[r + 2]), b[r + 3]); }
    const float m = __builtin_fmaxf(m0, m1);
    auto rr = __builtin_amdgcn_permlane32_swap(__float_as_uint(m), __float_as_uint(m), false, false);
    return __builtin_fmaxf(__uint_as_float(rr[0]), __uint_as_float(rr[1]));
}
__device__ __forceinline__ void attn_unit(LAS unsigned char* lds, const bf16_t* QB, const bf16_t* KB, const bf16_t* VT, bf16_t* O,
                                          int qrow0, int nq_valid, int qpos0, int kvrow0, int ntiles, int kvlen, int h, bool causal) {
    const int tid = threadIdx.x, lane = tid & 63, ql = lane & 31, hi = lane >> 5;
    const int wid = __builtin_amdgcn_readfirstlane(tid >> 6);
    const bool wactive = 32 * wid < nq_valid;
    const int tlim = causal ? ((qpos0 + 32 * wid) >> 6) : (ntiles - 1);
    int qr = qrow0 + 32 * wid + ql; qr = qr < MT ? qr : MT - 1;
    const bf16_t* qp = QB + (size_t)qr * 768 + h * 96 + 8 * hi;
    bf16x8 qf[6];
#pragma unroll
    for (int j = 0; j < 6; ++j) qf[j] = *(const bf16x8*)(qp + 16 * j);
    const int kr0 = tid / 12, kc0 = tid % 12, kr1 = (tid + 512) / 12, kc1 = (tid + 512) % 12, vr = tid >> 3, vc = tid & 7;
    const bf16_t* kg0 = KB + (size_t)(kvrow0 + kr0) * 768 + h * 96 + kc0 * 8;
    const bf16_t* kg1 = KB + (size_t)(kvrow0 + kr1) * 768 + h * 96 + kc1 * 8;
    const bf16_t* vg = VT + (size_t)(h * 64 + vr) * VT_LD + kvrow0 + vc * 8;
    const int kl0 = kr0 * AK_PITCH + kc0 * 16, kl1 = kr1 * AK_PITCH + kc1 * 16, vl = AV_OFF + vr * AV_PITCH + vc * 16;
    u32x4 rk0, rk1 = {0u, 0u, 0u, 0u}, rv;
#define A_LOADK(t) do { rk0 = *(const u32x4*)(kg0 + (size_t)(t) * 64 * 768); if (tid < 256) rk1 = *(const u32x4*)(kg1 + (size_t)(t) * 64 * 768); } while (0)
#define A_LOADV(t) do { rv = *(const u32x4*)(vg + (t) * 64); } while (0)
#define A_STOREK(b) do { *(LAS u32x4*)(lds + (b) * AK_BYTES + kl0) = rk0; if (tid < 256) *(LAS u32x4*)(lds + (b) * AK_BYTES + kl1) = rk1; } while (0)
#define A_STOREV(b) do { *(LAS u32x2*)(lds + (b) * AV_BYTES + vl) = (u32x2){rv.x, rv.y}; *(LAS u32x2*)(lds + (b) * AV_BYTES + vl + 8) = (u32x2){rv.z, rv.w}; } while (0)
#define QK_TILE(S0, S1, buf) do { const LAS unsigned char* kb_ = lds + (buf) * AK_BYTES + ql * AK_PITCH + hi * 16; \
        _Pragma("unroll") for (int r_ = 0; r_ < 16; ++r_) { S0[r_] = -mref; S1[r_] = -mref; } \
        _Pragma("unroll") for (int j_ = 0; j_ < 6; ++j_) { \
            const bf16x8 ka_ = *(const LAS bf16x8*)(kb_ + j_ * 32), kb2_ = *(const LAS bf16x8*)(kb_ + 32 * AK_PITCH + j_ * 32); \
            S0 = __builtin_amdgcn_mfma_f32_32x32x16_bf16(ka_, qf[j_], S0, 0, 0, 0); S1 = __builtin_amdgcn_mfma_f32_32x32x16_bf16(kb2_, qf[j_], S1, 0, 0, 0); } } while (0)
#define KMASK(S0, S1, t) do { if ((t) * 64 + 64 > kvlen) { _Pragma("unroll") for (int r_ = 0; r_ < 16; ++r_) { const int key_ = (t) * 64 + (r_ & 3) + 8 * (r_ >> 2) + 4 * hi; \
        if (key_ >= kvlen) S0[r_] = -1e30f; if (key_ + 32 >= kvlen) S1[r_] = -1e30f; } } } while (0)
    float mref = 0.f, lrun = 0.f;
    f32x16 o0, o1, sc0, sc1, sn0, sn1;
#pragma unroll
    for (int r = 0; r < 16; ++r) { o0[r] = 0.f; o1[r] = 0.f; sc0[r] = 0.f; sc1[r] = 0.f; }
    A_LOADK(0); A_LOADV(0); A_STOREK(0); A_STOREV(0);
    __syncthreads();
    if (ntiles > 1) A_LOADK(1);
    if (wactive) {
        QK_TILE(sc0, sc1, 0); KMASK(sc0, sc1, 0);
        const float mx = rowmax32(sc0, sc1); mref = mx;
#pragma unroll
        for (int r = 0; r < 16; ++r) { sc0[r] -= mx; sc1[r] -= mx; }
    }
    if (ntiles > 1) A_STOREK(1);
    __syncthreads();
    for (int t = 0; t < ntiles; ++t) {
        if (t + 2 < ntiles) A_LOADK(t + 2);
        if (t + 1 < ntiles) A_LOADV(t + 1);
        if (wactive && t <= tlim) {
            bf16x8 kf[12];
            const LAS unsigned char* kbq = lds + ((t + 1) & 1) * AK_BYTES + ql * AK_PITCH + hi * 16;
            { const LAS unsigned char* kb_ = lds + ((t + 1) & 1) * AK_BYTES + ql * AK_PITCH + hi * 16;
#pragma unroll
              for (int j = 0; j < 4; ++j) { kf[2 * j] = *(const LAS bf16x8*)(kb_ + j * 32); kf[2 * j + 1] = *(const LAS bf16x8*)(kb_ + 32 * AK_PITCH + j * 32); }
            }
            __builtin_amdgcn_sched_barrier(0);
            if (t > 0) {
                KMASK(sc0, sc1, t);
                const float mx = rowmax32(sc0, sc1);
                if (__builtin_expect(__any(mx > ATT_THR), 0)) {
                    const float dl = __builtin_fmaxf(mx, 0.f), f = __builtin_amdgcn_exp2f(-dl);
                    mref += dl; lrun *= f;
#pragma unroll
                    for (int r = 0; r < 16; ++r) { sc0[r] -= dl; sc1[r] -= dl; o0[r] *= f; o1[r] *= f; }
                }
            }
#pragma unroll
            for (int r = 0; r < 16; ++r) { sn0[r] = -mref; sn1[r] = -mref; }
#pragma unroll
            for (int j = 4; j < 6; ++j) { kf[2 * j] = *(const LAS bf16x8*)(kbq + j * 32); kf[2 * j + 1] = *(const LAS bf16x8*)(kbq + 32 * AK_PITCH + j * 32); }
#pragma unroll
            for (int j = 0; j < 6; ++j) { sn0 = __builtin_amdgcn_mfma_f32_32x32x16_bf16(kf[2 * j], qf[j], sn0, 0, 0, 0); sn1 = __builtin_amdgcn_mfma_f32_32x32x16_bf16(kf[2 * j + 1], qf[j], sn1, 0, 0, 0); }
            float ls = 0.f;
#pragma unroll
            for (int r = 0; r < 16; ++r) { sc0[r] = __builtin_amdgcn_exp2f(sc0[r]); sc1[r] = __builtin_amdgcn_exp2f(sc1[r]); ls += sc0[r] + sc1[r]; }
            lrun += ls;
            bf16x8 pf[4];
#pragma unroll
            for (int jp = 0; jp < 2; ++jp) {
                u32x4 w; w.x = pk2(sc0[8 * jp + 0], sc0[8 * jp + 1]); w.y = pk2(sc0[8 * jp + 2], sc0[8 * jp + 3]); w.z = pk2(sc0[8 * jp + 4], sc0[8 * jp + 5]); w.w = pk2(sc0[8 * jp + 6], sc0[8 * jp + 7]);
                pf[jp] = __builtin_bit_cast(bf16x8, w);
                u32x4 x; x.x = pk2(sc1[8 * jp + 0], sc1[8 * jp + 1]); x.y = pk2(sc1[8 * jp + 2], sc1[8 * jp + 3]); x.z = pk2(sc1[8 * jp + 4], sc1[8 * jp + 5]); x.w = pk2(sc1[8 * jp + 6], sc1[8 * jp + 7]);
                pf[2 + jp] = __builtin_bit_cast(bf16x8, x);
            }
            __builtin_amdgcn_sched_barrier(0);
            u32x2 vf[16];
            { const LAS unsigned char* vb_ = lds + AV_OFF + (t & 1) * AV_BYTES + ql * AV_PITCH + hi * 8;
#pragma unroll
              for (int jp = 0; jp < 4; ++jp) { vf[4 * jp] = *(const LAS u32x2*)(vb_ + jp * 32); vf[4 * jp + 1] = *(const LAS u32x2*)(vb_ + jp * 32 + 16);
                  vf[4 * jp + 2] = *(const LAS u32x2*)(vb_ + 32 * AV_PITCH + jp * 32); vf[4 * jp + 3] = *(const LAS u32x2*)(vb_ + 32 * AV_PITCH + jp * 32 + 16); } }
#pragma unroll
            for (int jp = 0; jp < 4; ++jp) {
                const u32x2 a0 = vf[4 * jp], a1 = vf[4 * jp + 1], c0 = vf[4 * jp + 2], c1 = vf[4 * jp + 3];
                const bf16x8 va = __builtin_bit_cast(bf16x8, (u32x4){a0.x, a0.y, a1.x, a1.y}), vc2 = __builtin_bit_cast(bf16x8, (u32x4){c0.x, c0.y, c1.x, c1.y});
                o0 = __builtin_amdgcn_mfma_f32_32x32x16_bf16(va, pf[jp], o0, 0, 0, 0);
                o1 = __builtin_amdgcn_mfma_f32_32x32x16_bf16(vc2, pf[jp], o1, 0, 0, 0);
            }
            sc0 = sn0; sc1 = sn1;
        }
        if (t + 2 < ntiles) A_STOREK(t & 1);
        if (t + 1 < ntiles) A_STOREV((t + 1) & 1);
        __syncthreads();
    }
#undef A_LOADK
#undef A_LOADV
#undef A_STOREK
#undef A_STOREV
#undef QK_TILE
#undef KMASK
    float lt;
    { auto rr = __builtin_amdgcn_permlane32_swap(__float_as_uint(lrun), __float_as_uint(lrun), false, false); lt = __uint_as_float(rr[0]) + __uint_as_float(rr[1]); }
    if (wactive && (32 * wid + ql) < nq_valid) {
        const float inv = 1.0f / lt;
        bf16_t* op = O + (size_t)(qrow0 + 32 * wid + ql) * 512 + h * 64 + 4 * hi;
#pragma unroll
        for (int g = 0; g < 4; ++g) {
            u32x2 w0, w1; w0.x = pk2(o0[4 * g] * inv, o0[4 * g + 1] * inv); w0.y = pk2(o0[4 * g + 2] * inv, o0[4 * g + 3] * inv);
            w1.x = pk2(o1[4 * g] * inv, o1[4 * g + 1] * inv); w1.y = pk2(o1[4 * g + 2] * inv, o1[4 * g + 3] * inv);
            *(u32x2*)(op + 8 * g) = w0; *(u32x2*)(op + 32 + 8 * g) = w1;
        }
    }
}
__device__ __forceinline__ void phase_attn(const Params& p, LAS unsigned char* lds) {
    unsigned char* ws = p.ws;
    const bf16_t* QB = (const bf16_t*)(ws + WS_QB); const bf16_t* KB = (const bf16_t*)(ws + WS_KB); const bf16_t* VT = (const bf16_t*)(ws + WS_VT); bf16_t* O = (bf16_t*)(ws + WS_O);
    const bool swz = (gridDim.x == 256);
    for (int v0 = blockIdx.x; v0 < 256; v0 += gridDim.x) {
        const int v = swz ? ((v0 & 7) * 32 + (v0 >> 3)) : v0;
        const int bh = v >> 1, par = v & 1, b = bh >> 3, h = bh & 7;
        for (int i = 0; i < 8; ++i) {
            const int jj = 2 * (i >> 1) + par, qb = (i & 1) ? 15 - jj : jj;
            attn_unit(lds, QB, KB, VT, O, b * TP + qb * 256, 256, qb * 256, b * TP, 4 * qb + 4, 1 << 30, h, true);
        }
        const int sb = v >> 3, sh = v & 7;
        attn_unit(lds, QB, KB, VT, O, MP + sb * TS, TS, 0, MP + sb * KVSEQ, (KVSEQ + 63) / 64, KVSEQ, sh, false);
    }
}

__device__ __forceinline__ void phase_final(const Params& p) {
    const int tid = threadIdx.x, lane = tid & 63, wave = tid >> 6;
    const int gw = blockIdx.x * 8 + wave, NGW = gridDim.x * 8;
    const float* slots = (const float*)(p.ws + WS_SLOT3); const float* g = p.in[27];
    f32x4 gv[4];
#pragma unroll
    for (int j = 0; j < 4; ++j) gv[j] = *(const f32x4*)(g + 4 * lane + 256 * j);
    for (int row = gw; row < MT; row += 2 * NGW) {
        const int rowb = row + NGW; const bool vb = rowb < MT; const int rb = vb ? rowb : row;
        float* x = p.out + OUT_Y + (size_t)row * 1024; float* y = p.out + OUT_Y + (size_t)rb * 1024;
        f32x4 v[4], u[4];
#pragma unroll
        for (int j = 0; j < 4; ++j) { v[j] = *(const f32x4*)(x + 4 * lane + 256 * j); u[j] = *(const f32x4*)(y + 4 * lane + 256 * j); }
        const float rs = rs_from_slots(slots + (size_t)row * 16, 1.0f / 1024.0f, RMS_EPS), rt = rs_from_slots(slots + (size_t)rb * 16, 1.0f / 1024.0f, RMS_EPS);
#pragma unroll
        for (int j = 0; j < 4; ++j) *(f32x4*)(x + 4 * lane + 256 * j) = v[j] * rs * gv[j];
        if (vb) {
#pragma unroll
            for (int j = 0; j < 4; ++j) *(f32x4*)(y + 4 * lane + 256 * j) = u[j] * rt * gv[j];
        }
    }
}

#define XB_TMO      128
#define XB_XCNT(j)  (256  + 64 * (j))
#define XB_XSUB(j)  (1280 + 64 * (j))
#define XB_XGEN(j)  (2304 + 64 * (j))
#define XB_TOP      3328
#define XB_TOPGEN   3392
#define XCD_BAR_WORDS 3456
#define XB_SPIN_CAP (1u << 18)

__device__ __forceinline__ unsigned xb_ld(unsigned* p)              { return __hip_atomic_load(p, __ATOMIC_RELAXED, __HIP_MEMORY_SCOPE_AGENT); }
__device__ __forceinline__ unsigned xb_add(unsigned* p, unsigned v) { return __hip_atomic_fetch_add(p, v, __ATOMIC_RELAXED, __HIP_MEMORY_SCOPE_AGENT); }
__device__ __forceinline__ unsigned xb_xcc_id() { return (unsigned)__builtin_amdgcn_s_getreg((3 << 11) | 20) & 0xFu; }
#define XB_SPIN(cond, bar) do { unsigned _sp = 0; while (cond) { __builtin_amdgcn_s_sleep(1); \
    if ((++_sp & 255u) == 0u) { if (xb_ld(&(bar)[XB_TMO])) break; if (_sp > XB_SPIN_CAP) { atomicAdd(&(bar)[XB_TMO], 1u); break; } } } } while (0)

struct XcdBarrier {
    unsigned* bar; unsigned x;
    volatile LAS unsigned* st;
};

__device__ __forceinline__ XcdBarrier xcd_barrier_post(unsigned* bar, volatile LAS unsigned* st) {
    XcdBarrier b; b.bar = bar; b.x = xb_xcc_id(); b.st = st;
    if (threadIdx.x == 0) (void)xb_add(&bar[XB_XCNT(b.x)], 1u);
    return b;
}
__device__ __forceinline__ void xcd_barrier_complete(unsigned* bar, unsigned x, unsigned& nloc, unsigned& nx) {
    const unsigned G = gridDim.x * gridDim.y * gridDim.z;
    unsigned sum, cnt, mine, sp = 0u;
    for (;;) {
        sum = 0u; cnt = 0u; mine = 0u;
#pragma unroll
        for (unsigned j = 0; j < 16; ++j) { const unsigned c = xb_ld(&bar[XB_XCNT(j)]); sum += c; cnt += (c > 0u) ? 1u : 0u; mine = (j == x) ? c : mine; }
        if (sum == G) break;
        __builtin_amdgcn_s_sleep(1);
        if ((++sp & 255u) == 0u) { if (xb_ld(&bar[XB_TMO])) break; if (sp > XB_SPIN_CAP) { atomicAdd(&bar[XB_TMO], 1u); break; } }
    }
    nloc = mine > 0u ? mine : 1u; nx = cnt > 0u ? cnt : 1u;
}

__device__ __forceinline__ void xcd_barrier(const XcdBarrier& b) {
    asm volatile("s_waitcnt vmcnt(0)" ::: "memory");
    __syncthreads();
    if (threadIdx.x == 0) {
        unsigned* bar = b.bar;
        __builtin_amdgcn_s_waitcnt(0);
        unsigned nloc = b.st[0], nx = b.st[1];
        if (nloc == 0u) { xcd_barrier_complete(bar, b.x, nloc, nx); b.st[0] = nloc; b.st[1] = nx; }
        const unsigned old = xb_add(&bar[XB_XSUB(b.x)], 1u);
        const unsigned gen = old / nloc;
        if (old + 1u == (gen + 1u) * nloc) {
            __builtin_amdgcn_fence(__ATOMIC_RELEASE, "agent");
            asm volatile("s_waitcnt vmcnt(0)" ::: "memory");
            const unsigned og = xb_add(&bar[XB_TOP], 1u);
            const unsigned tg = og / nx;
            if (og + 1u == (tg + 1u) * nx) xb_add(&bar[XB_TOPGEN], 1u);
            else XB_SPIN(xb_ld(&bar[XB_TOPGEN]) == tg, bar);
            __builtin_amdgcn_fence(__ATOMIC_ACQUIRE, "agent");
            xb_add(&bar[XB_XGEN(b.x)], 1u);
            asm volatile("s_waitcnt vmcnt(0)" ::: "memory");
        } else {
            XB_SPIN(xb_ld(&bar[XB_XGEN(b.x)]) == gen, bar);
            __builtin_amdgcn_fence(__ATOMIC_ACQUIRE, "agent");
            asm volatile("s_waitcnt vmcnt(0)" ::: "memory");
        }
    }
    __syncthreads();
}


__global__ void __launch_bounds__(512, 2) mega_fwd(Params p) {
    extern __shared__ __attribute__((aligned(16))) unsigned char lds_raw[];
    LAS unsigned char* lds = (LAS unsigned char*)lds_raw;
    cg::grid_group grid = cg::this_grid();
    unsigned char* ws = p.ws;
    volatile LAS unsigned* xst = (volatile LAS unsigned*)(lds + 131072);
    if (threadIdx.x < 2) xst[threadIdx.x] = 0u;
    __syncthreads();
    XcdBarrier xbar = xcd_barrier_post((unsigned*)(ws + WS_BAR), xst);
    grid.sync();
    const int lo = p.ph_lo, hi = p.ph_hi;
#define IN(k) (lo <= (k) && (k) < hi)
#define SEAM(k) do { if (IN(k) && IN((k) + 1)) { xcd_barrier(xbar); } } while (0)
    bf16_t* G = (bf16_t*)(p.out + OUT_Y);
    if (IN(0)) { phase0(p, lds); }
    SEAM(0);
    const int G_ = (int)gridDim.x, bx_ = (int)blockIdx.x;
#define TAIL_SPLIT(units, nx, vb, vg) const int nx = (units) % G_; const int vb = bx_ - nx, vg = G_ - nx
    if (IN(1)) { EpiIn E{(bf16_t*)(ws + WS_ZS), (bf16_t*)(ws + WS_U), G, (float*)(ws + WS_SLOTQ)}; run_gemm(lds, (const bf16_t*)(ws + WS_XN), (const bf16_t*)(ws + WS_WIN), MT, NZ, 1024, E);
        TAIL_SPLIT((MT / 256) * (NZ / 256), nx1, vb1, vg1); if (vb1 >= 0) phase_cache(p, vb1, vg1); }
    SEAM(1);
    if (IN(2)) { phase_mid_tokens(p); phase_mid_conv(p, lds); }
    SEAM(2);
    if (IN(3)) {
        { EpiQ E{(bf16_t*)(ws + WS_QB), (const float*)(ws + WS_ROPE), (const float*)(ws + WS_SLOTQ)}; run_gemm(lds, (const bf16_t*)(ws + WS_ZS), (const bf16_t*)(ws + WS_WUQ), MT, 768, QL, E, 0, ZW); }
        { EpiK E{(bf16_t*)(ws + WS_KB)}; run_gemm(lds, (const bf16_t*)(ws + WS_LATKV), (const bf16_t*)(ws + WS_WUK), MKV, 512, 256, E, 248); }
        { EpiStore E{(bf16_t*)(ws + WS_VT), (size_t)VT_LD}; run_gemm(lds, (const bf16_t*)(ws + WS_WUV), (const bf16_t*)(ws + WS_LATKV), 512, MKV, 256, E, 240); }
    }
    SEAM(3);
    if (IN(4)) { phase_attn(p, lds); }
    SEAM(4);
    if (IN(5)) {
        { EpiGate<false> E{(bf16_t*)(ws + WS_M1), G, 0}; run_gemm(lds, (const bf16_t*)(ws + WS_O), (const bf16_t*)(ws + WS_WAO), MT, 1024, 512, E); }
        { EpiGate<true> E{(bf16_t*)(ws + WS_M1), G, 1024}; run_gemm(lds, (const bf16_t*)(ws + WS_CACT), (const bf16_t*)(ws + WS_WCO), MT, 1024, 512, E); }
    }
    SEAM(5);
    if (IN(6)) { EpiRes E{p.in[0], p.in[1], p.out + OUT_Y, (bf16_t*)(ws + WS_XN), (float*)(ws + WS_SLOT1)}; run_gemm(lds, (const bf16_t*)(ws + WS_M1), (const bf16_t*)(ws + WS_WOUT), MT, 1024, 1024, E);
        TAIL_SPLIT((MT / 256) * 4, nx6, vb6, vg6); if (vb6 >= 0) { phase_pbf(p, vb6, vg6); tr_range(p, lds, W_ITEMS_EARLY, W_ITEMS_UP, vb6, vg6); } }
    SEAM(6);
    if (IN(7)) { { EpiUp E{(bf16_t*)(ws + WS_H), (const float*)(ws + WS_SLOT1)}; run_gemm(lds, (const bf16_t*)(ws + WS_XN), (const bf16_t*)(ws + WS_WUP), MT, 4096, 1024, E); }
        TAIL_SPLIT((MT / 256) * 16, nx7, vb7, vg7); if (vb7 >= 0) tr_range(p, lds, W_ITEMS_UP, W_ITEMS_ALL, vb7, vg7); }
    SEAM(7);
    if (IN(8)) { EpiRes E{p.out + OUT_Y, p.out + OUT_Y + (size_t)MP * 1024, p.out + OUT_Y, (bf16_t*)(ws + WS_XN), (float*)(ws + WS_SLOT2)};
        run_gemm(lds, (const bf16_t*)(ws + WS_H), (const bf16_t*)(ws + WS_WDN), MT, 1024, 4096, E);
        TAIL_SPLIT((MT / 256) * 4, nx8, vb8, vg8);
        if (vb8 >= 0) {
            int kk = 256; asm volatile("" : "+s"(kk));
            pg8::Gemm g{(const bf16_t*)(ws + WS_PBF), (const bf16_t*)(ws + WS_WPP), MT, 1024, kk, 256, 256}; pg8::StaticOrder S; S.init(MT, 1024, vg8, vb8);
            EpiStore E{(bf16_t*)(ws + WS_PP), (size_t)1024};
            pg8::gemm_phase<EpiStore, pg8::StaticOrder, true, true>(lds, g, S, E);
        } }
    SEAM(8);
    if (IN(9)) { EpiPle E{p.out + OUT_Y, (const bf16_t*)(ws + WS_PP), (const float*)(ws + WS_SLOT2), (float*)(ws + WS_SLOT3)}; run_gemm(lds, (const bf16_t*)(ws + WS_XN), (const bf16_t*)(ws + WS_WPG), MT, 1024, 1024, E); }
    SEAM(9);
    if (IN(10)) { phase_final(p); }
#undef IN
#undef SEAM
}

extern "C" void kernel_launch(void* const* d_in, const int* in_sizes, int n_in, void* d_out, int out_size, void* d_ws, size_t ws_size, hipStream_t stream) {
    static int grid_blocks = 0;
    if (grid_blocks == 0) {
        int dev = 0, cus = 0, per_cu = 0;
        (void)hipGetDevice(&dev);
        (void)hipDeviceGetAttribute(&cus, hipDeviceAttributeMultiprocessorCount, dev);
        if (hipFuncSetAttribute((const void*)mega_fwd, hipFuncAttributeMaxDynamicSharedMemorySize, LDS_BYTES) != hipSuccess) fprintf(stderr, "kernel_launch: hipFuncSetAttribute failed\n");
        if (hipOccupancyMaxActiveBlocksPerMultiprocessor(&per_cu, (const void*)mega_fwd, 512, LDS_BYTES) != hipSuccess || per_cu < 1) { fprintf(stderr, "kernel_launch: occupancy query says %d\n", per_cu); per_cu = 1; }
        (void)hipGetLastError();
        grid_blocks = cus * (per_cu > 1 ? 1 : per_cu);
        if (grid_blocks <= 0) grid_blocks = 256;
        if (n_in != 28 || ws_size < ((size_t)1 << 30)) fprintf(stderr, "kernel_launch: unexpected n_in %d / ws_size %zu\n", n_in, ws_size);
    }
    Params p{};
    for (int i = 0; i < 28; ++i) p.in[i] = (const float*)d_in[i];
    p.out = (float*)d_out; p.ws = (unsigned char*)d_ws; p.ph_lo = 0; p.ph_hi = 11;
    (void)hipMemsetAsync((unsigned char*)d_ws + WS_BAR, 0, 16384, stream);
    void* args[] = {&p};
    hipError_t e = hipLaunchCooperativeKernel((const void*)mega_fwd, dim3(grid_blocks), dim3(512), args, LDS_BYTES, stream);
    if (e != hipSuccess) fprintf(stderr, "cooperative launch failed: %s (grid %d)\n", hipGetErrorString(e), grid_blocks);
}
```

```cpp
#include <hip/hip_runtime.h>
#include <hip/hip_cooperative_groups.h>
#include <cstdio>
#include <cstdint>
#include <cmath>
namespace cg = cooperative_groups;
namespace pg8 {
#define PG8_LAS __attribute__((address_space(3)))
typedef unsigned short bf16_t;
typedef short bf16x8 __attribute__((ext_vector_type(8)));
typedef float f32x4 __attribute__((ext_vector_type(4)));
typedef unsigned u32x4 __attribute__((ext_vector_type(4)));
constexpr int BM = 256, BK = 64, HALF = 128, HTB = HALF * BK * 2  , STAGE_BYTES = 8 * HTB, NXCD = 8, WGM = 8;

__host__ __device__ __forceinline__ int lds_byte(int r, int c) { const int st = (r >> 4) * 2 + (c >> 5), rr = r & 15, cc = c & 31, ob = rr * 64 + cc * 2; return st * 1024 + (ob ^ (((ob >> 9) & 1) << 5)); }
__host__ __device__ __forceinline__ void stage_rc(int b, int& R, int& C) { const int st = b / 1024, sb = b % 1024, swz = sb ^ (((sb >> 9) & 1) << 5); R = (st >> 1) * 16 + swz / 64; C = (st & 1) * 32 + (swz % 64) / 2; }
__host__ __device__ __forceinline__ int perm32(int rho) { const int n = rho >> 4, i = rho & 15; return 8 * (i >> 2) + 4 * n + (i & 3); }

struct Unit { int pm, pn; };
struct Gemm { const bf16_t* A; const bf16_t* Bt; int M, N, K, lda, ldb; };

struct StaticOrder {
    int nM, nN, nwg, G, c;
    __host__ __device__ void init(int M, int N, int G_, int c_) { nM = M / BM; nN = N / BM; nwg = nM * nN; G = G_; c = c_; }
    __host__ __device__ bool next(int i, Unit& u) const {
        const long L = (long)i * G + c; if (L >= nwg) return false;
        int wgid = (int)L; { const int q = nwg / NXCD, r = nwg % NXCD, xcd = wgid % NXCD, off = wgid / NXCD; wgid = (xcd < r ? xcd * (q + 1) : r * (q + 1) + (xcd - r) * q) + off; }
        const int nig = WGM * nN, gid = wgid / nig, fm = gid * WGM, gsz = (nM - fm) < WGM ? (nM - fm) : WGM;
        u.pm = fm + ((wgid % nig) % gsz); u.pn = (wgid % nig) / gsz; return true;
    }
    __device__ __forceinline__ void a_ready(const Unit&) const {}
    __device__ __forceinline__ void done(const Unit&) const {}
};

__device__ __forceinline__ unsigned cvt_pk_bf16(float lo, float hi) { unsigned r; asm volatile("v_cvt_pk_bf16_f32 %0, %1, %2" : "=v"(r) : "v"(lo), "v"(hi)); return r; }
template <class Epi, class Sched, bool ALIGN_EPI = false, bool SP2 = false>
__device__ __forceinline__ void gemm_phase(PG8_LAS unsigned char* lds, const Gemm g, const Sched& S, const Epi& E) {
    const int tid = threadIdx.x, wid = __builtin_amdgcn_readfirstlane(tid >> 6), lane = tid & 63, wr = wid >> 2, wc = wid & 3, fr = lane & 15, fq = lane >> 4;
    const int K = g.K, nt = K / BK, LDA = g.lda, LDB = g.ldb;
    unsigned voffA[2], voffB[2];
#pragma unroll
    for (int i = 0; i < 2; ++i) { int R, C; stage_rc(tid * 16 + i * 8192, R, C); const int Rb = Epi::PERM ? ((R & ~31) + perm32(R & 31)) : R;
        voffA[i] = (unsigned)(R * LDA + C) * 2u; voffB[i] = (unsigned)(Rb * LDB + C) * 2u; }
    const size_t kstep = (size_t)(BK * 2);
    const size_t hstepA = (size_t)HALF * LDA * 2, hstepB = (size_t)HALF * LDB * 2;
    const size_t tstepA = 2 * hstepA, tstepB = 2 * hstepB;
    const unsigned ldsw = (unsigned)wid * 1024u;
    const int aoff = lds_byte(wr * 64 + fr, fq * 8), boff = lds_byte(wc * 32 + fr, fq * 8);
#define PG8_SA(b, h) (((b) * 2 + (h)) * HTB)
#define PG8_SB(b, h) ((4 + (b) * 2 + (h)) * HTB)
#define PG8_STAGE(bufoff, gbase, voff) do { _Pragma("unroll") for (int _i = 0; _i < 2; ++_i) \
        __builtin_amdgcn_global_load_lds((const unsigned*)((const char*)(gbase) + (voff)[_i]), (PG8_LAS unsigned*)(lds + (bufoff) + ldsw + _i * 8192), 16, 0, 0); } while (0)
#define PG8_LDA(dst, b, h) do { _Pragma("unroll") for (int m = 0; m < 4; ++m) _Pragma("unroll") for (int k = 0; k < 2; ++k) dst[m][k] = *(const PG8_LAS bf16x8*)(lds + PG8_SA(b, h) + aoff + m * 2048 + k * 1024); } while (0)
#define PG8_LDB(dst, b, h) do { _Pragma("unroll") for (int n = 0; n < 2; ++n) _Pragma("unroll") for (int k = 0; k < 2; ++k) dst[n][k] = *(const PG8_LAS bf16x8*)(lds + PG8_SB(b, h) + boff + n * 2048 + k * 1024); } while (0)
#define PG8_MMA(ai, bj, At, Bt) do { __builtin_amdgcn_s_setprio(1); _Pragma("unroll") for (int m = 0; m < 4; ++m) _Pragma("unroll") for (int n = 0; n < 2; ++n) _Pragma("unroll") for (int k = 0; k < 2; ++k) \
        acc[ai][bj][m][n] = __builtin_amdgcn_mfma_f32_16x16x32_bf16(Bt[n][k], At[m][k], acc[ai][bj][m][n], 0, 0, 0); __builtin_amdgcn_s_setprio(0); } while (0)
#define PG8_WAIT_V(n) asm volatile("s_waitcnt vmcnt(" #n ")" ::: "memory")
#define PG8_WAIT_L(n) asm volatile("s_waitcnt lgkmcnt(" #n ")" ::: "memory")
#define PG8_BAR __builtin_amdgcn_s_barrier()
#define PG8_SCHED __builtin_amdgcn_sched_barrier(0)
    Unit cur, nxt; int ui = 0;
    if (!S.next(0, cur)) return;
    f32x4 acc[2][2][4][2];
#pragma unroll
    for (int a = 0; a < 2; ++a)
#pragma unroll
        for (int b = 0; b < 2; ++b)
#pragma unroll
            for (int m = 0; m < 4; ++m)
#pragma unroll
                for (int n = 0; n < 2; ++n) acc[a][b][m][n] = (f32x4){0.f, 0.f, 0.f, 0.f};
    bf16x8 At[4][2], B0[2][2], B1[2][2];
    const char* cA = (const char*)g.A + (size_t)cur.pm * tstepA; const char* cB = (const char*)g.Bt + (size_t)cur.pn * tstepB;
    S.a_ready(cur);
    if constexpr (SP2) {
        PG8_STAGE(PG8_SB(0, 0), cB, voffB); PG8_STAGE(PG8_SB(0, 1), cB + hstepB, voffB); PG8_STAGE(PG8_SA(0, 0), cA, voffA); PG8_STAGE(PG8_SA(0, 1), cA + hstepA, voffA);
        if (wr == 1) PG8_BAR;
        PG8_WAIT_V(2); PG8_BAR;
        PG8_STAGE(PG8_SB(1, 0), cB + kstep, voffB); PG8_STAGE(PG8_SA(1, 0), cA + kstep, voffA); PG8_STAGE(PG8_SB(1, 1), cB + hstepB + kstep, voffB);
        PG8_WAIT_V(6); PG8_BAR;
    } else {
        PG8_STAGE(PG8_SB(0, 0), cB, voffB); PG8_STAGE(PG8_SA(0, 0), cA, voffA); PG8_STAGE(PG8_SB(0, 1), cB + hstepB, voffB); PG8_STAGE(PG8_SA(0, 1), cA + hstepA, voffA);
        if (wr == 1) PG8_BAR;
        PG8_WAIT_V(4); PG8_BAR;
        PG8_STAGE(PG8_SB(1, 0), cB + kstep, voffB); PG8_STAGE(PG8_SA(1, 0), cA + kstep, voffA); PG8_STAGE(PG8_SB(1, 1), cB + hstepB + kstep, voffB);
        PG8_WAIT_V(6); PG8_BAR;
    }
    for (;;) {
        const bool has_next = S.next(ui + 1, nxt);
        const char* nA = has_next ? (const char*)g.A + (size_t)nxt.pm * tstepA : cA; const char* nB = has_next ? (const char*)g.Bt + (size_t)nxt.pn * tstepB : cB;
#pragma unroll 1
        for (int t = 0; t < nt; t += 2) {
            const bool last = (t == nt - 2);
            const char* a1 = cA + (size_t)(t + 1) * kstep;
            const char* a2 = last ? nA : cA + (size_t)(t + 2) * kstep; const char* b2 = last ? nB : cB + (size_t)(t + 2) * kstep;
            const char* a3 = a2 + kstep; const char* b3 = b2 + kstep;
            if (last && has_next) S.a_ready(nxt);
            if constexpr (SP2) {
            PG8_LDB(B0, 0, 0); PG8_LDB(B1, 0, 1); PG8_SCHED; PG8_LDA(At, 0, 0); PG8_STAGE(PG8_SA(1, 1), a1 + hstepA, voffA);
            PG8_WAIT_V(8); PG8_WAIT_L(0); PG8_BAR; PG8_MMA(0, 0, At, B0); PG8_MMA(0, 1, At, B1); PG8_BAR; PG8_SCHED;
            PG8_LDA(At, 0, 1); PG8_STAGE(PG8_SB(0, 0), b2, voffB); PG8_STAGE(PG8_SB(0, 1), b2 + hstepB, voffB); PG8_STAGE(PG8_SA(0, 0), a2, voffA);
            PG8_WAIT_V(8); PG8_WAIT_L(0); PG8_BAR; PG8_MMA(1, 0, At, B0); PG8_MMA(1, 1, At, B1); PG8_BAR; PG8_SCHED;
            PG8_LDB(B0, 1, 0); PG8_LDB(B1, 1, 1); PG8_SCHED; PG8_LDA(At, 1, 0); PG8_STAGE(PG8_SA(0, 1), a2 + hstepA, voffA);
            PG8_WAIT_V(8); PG8_WAIT_L(0); PG8_BAR; PG8_MMA(0, 0, At, B0); PG8_MMA(0, 1, At, B1); PG8_BAR; PG8_SCHED;
            PG8_LDA(At, 1, 1); PG8_STAGE(PG8_SB(1, 0), b3, voffB); PG8_STAGE(PG8_SB(1, 1), b3 + hstepB, voffB); PG8_STAGE(PG8_SA(1, 0), a3, voffA);
            PG8_WAIT_V(8); PG8_WAIT_L(0); PG8_BAR; PG8_MMA(1, 0, At, B0); PG8_MMA(1, 1, At, B1); PG8_BAR; PG8_SCHED;
            } else {
            PG8_LDB(B0, 0, 0); PG8_SCHED; PG8_LDA(At, 0, 0); PG8_STAGE(PG8_SA(1, 1), a1 + hstepA, voffA);
            PG8_WAIT_L(8); PG8_BAR; PG8_WAIT_L(0); PG8_MMA(0, 0, At, B0); PG8_BAR; PG8_SCHED;
            PG8_LDB(B1, 0, 1); PG8_STAGE(PG8_SB(0, 0), b2, voffB);
            PG8_BAR; PG8_WAIT_L(0); PG8_MMA(0, 1, At, B1); PG8_BAR;
            PG8_LDA(At, 0, 1); PG8_STAGE(PG8_SA(0, 0), a2, voffA);
            PG8_BAR; PG8_WAIT_L(0); PG8_MMA(1, 0, At, B0); PG8_BAR; PG8_SCHED;
            PG8_STAGE(PG8_SB(0, 1), b2 + hstepB, voffB);
            PG8_WAIT_V(6); PG8_BAR; PG8_MMA(1, 1, At, B1); PG8_BAR;
            PG8_LDB(B0, 1, 0); PG8_SCHED; PG8_LDA(At, 1, 0); PG8_STAGE(PG8_SA(0, 1), a2 + hstepA, voffA);
            PG8_WAIT_L(8); PG8_BAR; PG8_WAIT_L(0); PG8_MMA(0, 0, At, B0); PG8_BAR; PG8_SCHED;
            PG8_LDB(B1, 1, 1); PG8_STAGE(PG8_SB(1, 0), b3, voffB);
            PG8_BAR; PG8_WAIT_L(0); PG8_MMA(0, 1, At, B1); PG8_BAR;
            PG8_LDA(At, 1, 1); PG8_STAGE(PG8_SA(1, 0), a3, voffA);
            PG8_BAR; PG8_WAIT_L(0); PG8_MMA(1, 0, At, B0); PG8_BAR; PG8_SCHED;
            PG8_STAGE(PG8_SB(1, 1), b3 + hstepB, voffB);
            PG8_WAIT_V(6); PG8_BAR; PG8_MMA(1, 1, At, B1); PG8_BAR;
            }
        }
        if constexpr (ALIGN_EPI) { if (wr == 0) PG8_BAR; }
        if constexpr (!Epi::AFTER_DRAIN) { E(acc, cur, wr, wc, fr, fq); S.done(cur); }
        if (!has_next) break;
#pragma unroll
        for (int a = 0; a < 2; ++a)
#pragma unroll
            for (int b = 0; b < 2; ++b)
#pragma unroll
                for (int m = 0; m < 4; ++m)
#pragma unroll
                    for (int n = 0; n < 2; ++n) acc[a][b][m][n] = (f32x4){0.f, 0.f, 0.f, 0.f};
        cur = nxt; cA = nA; cB = nB; ++ui;
        if constexpr (ALIGN_EPI) { if (wr == 1) PG8_BAR; }
    }
    PG8_WAIT_V(0);
    if constexpr (!ALIGN_EPI) { if (wr == 0) PG8_BAR; }
    PG8_BAR;
    if constexpr (Epi::AFTER_DRAIN) { E.fused(acc, cur, wr, wc, fr, fq, lds, wid, lane); S.done(cur); }
#undef PG8_SA
#undef PG8_SB
#undef PG8_STAGE
#undef PG8_LDA
#undef PG8_LDB
#undef PG8_MMA
#undef PG8_WAIT_V
#undef PG8_WAIT_L
#undef PG8_BAR
#undef PG8_SCHED
}
}

#define LAS __attribute__((address_space(3)))
typedef unsigned short bf16_t;
typedef short bf16x8 __attribute__((ext_vector_type(8)));
typedef float f32x4 __attribute__((ext_vector_type(4)));
typedef float f32x16 __attribute__((ext_vector_type(16)));
typedef unsigned u32x4 __attribute__((ext_vector_type(4)));
typedef unsigned u32x2 __attribute__((ext_vector_type(2)));
typedef float f32x2_t __attribute__((ext_vector_type(2)));
typedef __bf16 bf16x2_t __attribute__((ext_vector_type(2)));

constexpr int MP = 65536, MS = 512, MT = MP + MS;
constexpr int TP = 4096, TS = 16, PAST = 4096;
constexpr int KVSEQ = PAST + TS;
constexpr int MKV = MP + 32 * KVSEQ;
constexpr int VT_LD = MKV + 64;
constexpr int NZ = 4352, ZW = 1280, QL = 768;
constexpr int IN_W = 4128;
constexpr float RMS_EPS = 1e-6f, LN_EPS = 1e-5f;
constexpr float C2 = 0.10206207261596577f * 1.4426950408889634f;

constexpr size_t OUT_Y = 0, OUT_LATP = (size_t)MT * 1024, OUT_KRP = OUT_LATP + (size_t)MP * 256, OUT_CVP = OUT_KRP + (size_t)MP * 32,
                 OUT_LATS = OUT_CVP + 16 * 30 * 512, OUT_KRS = OUT_LATS + (size_t)MS * 256, OUT_CVS = OUT_KRS + (size_t)MS * 32;

constexpr size_t al256(size_t x) { return (x + 255) & ~(size_t)255; }
constexpr size_t WS_ROPE = 0;
constexpr size_t WS_WIN = al256(WS_ROPE + (size_t)KVSEQ * 16 * 8);
constexpr size_t WS_WUQ = al256(WS_WIN + (size_t)NZ * 1024 * 2);
constexpr size_t WS_WUK = al256(WS_WUQ + (size_t)768 * QL * 2);
constexpr size_t WS_WUV = al256(WS_WUK + (size_t)512 * 256 * 2);
constexpr size_t WS_WAO = al256(WS_WUV + (size_t)512 * 256 * 2);
constexpr size_t WS_WCO = al256(WS_WAO + (size_t)1024 * 512 * 2);
constexpr size_t WS_WOUT = al256(WS_WCO + (size_t)1024 * 512 * 2);
constexpr size_t WS_WUP = al256(WS_WOUT + (size_t)1024 * 1024 * 2);
constexpr size_t WS_WDN = al256(WS_WUP + (size_t)4096 * 1024 * 2);
constexpr size_t WS_WPG = al256(WS_WDN + (size_t)4096 * 1024 * 2);
constexpr size_t WS_WPP = al256(WS_WPG + (size_t)1024 * 1024 * 2);
constexpr size_t WS_SLOT1 = al256(WS_WPP + (size_t)1024 * 256 * 2);
constexpr size_t WS_SLOT2 = al256(WS_SLOT1 + (size_t)MT * 16 * 4);
constexpr size_t WS_SLOT3 = al256(WS_SLOT2 + (size_t)MT * 16 * 4);
constexpr size_t WS_SLOTQ = al256(WS_SLOT3 + (size_t)MT * 16 * 4);
constexpr size_t WS_XN = al256(WS_SLOTQ + (size_t)MT * 16 * 4);
constexpr size_t WS_O = WS_XN;
constexpr size_t WS_CACT = al256(WS_O + (size_t)MT * 512 * 2);
constexpr size_t WS_R = al256(WS_XN + (size_t)MT * 1024 * 2);
constexpr size_t WS_ZS = WS_R, WS_M1 = WS_R, WS_H = WS_R;
constexpr size_t WS_U = al256(WS_ZS + (size_t)MT * ZW * 2);
constexpr size_t WS_VT = WS_U;
constexpr size_t WS_LATKV = al256(WS_VT + (size_t)512 * VT_LD * 2);
constexpr size_t WS_KB = al256(WS_LATKV + (size_t)(MKV + 64) * 256 * 2);
constexpr size_t WS_QB = al256(WS_KB + (size_t)(MKV + 64) * 768 * 2);
constexpr size_t WS_END1 = al256(WS_QB + (size_t)MT * 768 * 2);
constexpr size_t WS_PP = al256(WS_H + (size_t)MT * 4096 * 2);
constexpr size_t WS_PBF = al256(WS_PP + (size_t)MT * 1024 * 2);
constexpr size_t WS_END2 = al256(WS_PBF + (size_t)MT * 256 * 2);
static_assert(WS_END1 <= ((size_t)1 << 30) && WS_END2 <= ((size_t)1 << 30), "workspace map exceeds 1 GiB");
static_assert(WS_CACT + (size_t)MT * 512 * 2 <= WS_R, "O|CACT overlay");
static_assert(WS_U + (size_t)MT * 512 * 2 <= WS_LATKV, "U under V^T");
static_assert(WS_M1 + (size_t)MT * 1024 * 2 <= WS_KB, "M1 overlay");
static_assert(WS_PBF >= WS_M1 + (size_t)MT * 1024 * 2 && WS_PBF >= WS_KB && WS_END2 <= WS_QB, "PBF / PP placement inside the dead K buffer");
constexpr size_t WS_BAR = ((size_t)1 << 30) - 65536;
static_assert(WS_END1 <= WS_BAR && WS_END2 <= WS_BAR, "barrier words");
constexpr int LDS_BYTES = 131072 + 1024;

struct Params { const float* in[28]; float* out; unsigned char* ws; int ph_lo, ph_hi; };

__device__ __forceinline__ unsigned pk2(float lo, float hi) { f32x2_t v = {lo, hi}; bf16x2_t b = __builtin_convertvector(v, bf16x2_t); return __builtin_bit_cast(unsigned, b); }
__device__ __forceinline__ float bflo(unsigned w) { return __uint_as_float(w << 16); }
__device__ __forceinline__ float bfhi(unsigned w) { return __uint_as_float(w & 0xffff0000u); }
__device__ __forceinline__ float sigmoidf_(float x) { return __builtin_amdgcn_rcpf(1.0f + __expf(-x)); }
__device__ __forceinline__ float wave_sum(float v) {
#pragma unroll
    for (int o = 1; o < 64; o <<= 1) v += __shfl_xor(v, o);
    return v;
}
__device__ __forceinline__ u32x4 pack8(const f32x4 a, const f32x4 b) { u32x4 w; w.x = pk2(a[0], a[1]); w.y = pk2(a[2], a[3]); w.z = pk2(b[0], b[1]); w.w = pk2(b[2], b[3]); return w; }
__device__ __forceinline__ void unpack8(const u32x4 w, f32x4& a, f32x4& b) { a = (f32x4){bflo(w.x), bfhi(w.x), bflo(w.y), bfhi(w.y)}; b = (f32x4){bflo(w.z), bfhi(w.z), bflo(w.w), bfhi(w.w)}; }
__device__ __forceinline__ float rs_from_slots(const float* s, float inv_n, float eps) {
    const f32x4 a = *(const f32x4*)s, b = *(const f32x4*)(s + 4), c = *(const f32x4*)(s + 8), d = *(const f32x4*)(s + 12);
    const float t = ((a[0] + a[1]) + (a[2] + a[3])) + ((b[0] + b[1]) + (b[2] + b[3])) + ((c[0] + c[1]) + (c[2] + c[3])) + ((d[0] + d[1]) + (d[2] + d[3]));
    return 1.0f / sqrtf(t * inv_n + eps);
}
__device__ __forceinline__ int pos_of_row(int row) { return row < MP ? (row & (TP - 1)) : PAST + ((row - MP) & (TS - 1)); }
__device__ __forceinline__ int kvrow_of_row(int row) { return row < MP ? row : MP + ((row - MP) >> 4) * KVSEQ + PAST + ((row - MP) & (TS - 1)); }

typedef pg8::Unit Unit;
#define EPI_ARGS const f32x4 (&acc)[2][2][4][2], const Unit& u, int wr, int wc, int fr, int fq
#define FOR_AI_M _Pragma("unroll") for (int ai = 0; ai < 2; ++ai) _Pragma("unroll") for (int m = 0; m < 4; ++m)
#define MEMFENCE asm volatile("" ::: "memory")

struct EpiIn {
    static constexpr bool PERM = true, AFTER_DRAIN = false;
    bf16_t* Zs; bf16_t* U; bf16_t* G; float* slotq;
    __device__ __forceinline__ void operator()(EPI_ARGS) const {
        const int pn = u.pn, cw = wc * 32 + 8 * fq;
        FOR_AI_M {
            const size_t row = (size_t)(u.pm * 256 + ai * 128 + wr * 64 + m * 16 + fr);
            if (pn < 5) {
#pragma unroll
                for (int bj = 0; bj < 2; ++bj) *(u32x4*)(Zs + row * ZW + pn * 256 + bj * 128 + cw) = pack8(acc[ai][bj][m][0], acc[ai][bj][m][1]);
                if (pn < 3) {
                    float ss = 0.f;
#pragma unroll
                    for (int bj = 0; bj < 2; ++bj)
#pragma unroll
                        for (int n = 0; n < 2; ++n) { const f32x4 v = acc[ai][bj][m][n]; ss += (v[0] * v[0] + v[1] * v[1]) + (v[2] * v[2] + v[3] * v[3]); }
                    ss += __shfl_xor(ss, 16); ss += __shfl_xor(ss, 32);
                    if (fq == 0) slotq[row * 16 + pn * 4 + wc] = ss;
                }
            } else if (pn < 9) {
                f32x4 v0, v1;
#pragma unroll
                for (int k = 0; k < 4; ++k) { v0[k] = acc[ai][0][m][0][k] * sigmoidf_(acc[ai][1][m][0][k]); v1[k] = acc[ai][0][m][1][k] * sigmoidf_(acc[ai][1][m][1][k]); }
                *(u32x4*)(U + row * 512 + (pn - 5) * 128 + cw) = pack8(v0, v1);
            } else {
#pragma unroll
                for (int bj = 0; bj < 2; ++bj) { f32x4 v0, v1;
#pragma unroll
                    for (int k = 0; k < 4; ++k) { v0[k] = sigmoidf_(acc[ai][bj][m][0][k]); v1[k] = sigmoidf_(acc[ai][bj][m][1][k]); }
                    *(u32x4*)(G + row * 2048 + (pn - 9) * 256 + bj * 128 + cw) = pack8(v0, v1); }
            }
        }
    }
};
struct EpiQ {
    static constexpr bool PERM = false, AFTER_DRAIN = false;
    bf16_t* QB; const float* rope; const float* slotq;
    __device__ __forceinline__ void operator()(EPI_ARGS) const {
#pragma unroll
        for (int bj = 0; bj < 2; ++bj) {
            const int c0 = u.pn * 256 + bj * 128 + wc * 32;
            const bool isrope = (c0 % 96) == 64;
            FOR_AI_M {
                const int row = u.pm * 256 + ai * 128 + wr * 64 + m * 16 + fr;
                bf16_t* dst = QB + (size_t)row * 768 + c0 + 4 * fq;
                const float* sq = slotq + (size_t)row * 16;
                const f32x4 s0 = *(const f32x4*)sq, s1 = *(const f32x4*)(sq + 4), s2 = *(const f32x4*)(sq + 8);
                const float rq = 1.0f / sqrtf((((s0[0] + s0[1]) + (s0[2] + s0[3])) + ((s1[0] + s1[1]) + (s1[2] + s1[3])) + ((s2[0] + s2[1]) + (s2[2] + s2[3]))) * (1.0f / (float)QL) + RMS_EPS);
                f32x4 a = acc[ai][bj][m][0] * rq, b = acc[ai][bj][m][1] * rq;
                if (isrope) {
                    const float* cs = rope + ((size_t)pos_of_row(row) * 16 + 4 * fq) * 2;
                    const f32x4 t0 = *(const f32x4*)cs, t1 = *(const f32x4*)(cs + 4);
                    const f32x4 c = {t0[0], t0[2], t1[0], t1[2]}, s = {t0[1], t0[3], t1[1], t1[3]};
                    const f32x4 o1 = a * c - b * s, o2 = b * c + a * s; a = o1; b = o2;
                }
                a = a * C2; b = b * C2;
                u32x2 w0, w1; w0.x = pk2(a[0], a[1]); w0.y = pk2(a[2], a[3]); w1.x = pk2(b[0], b[1]); w1.y = pk2(b[2], b[3]);
                *(u32x2*)dst = w0; *(u32x2*)(dst + 16) = w1;
                MEMFENCE;
            }
        }
    }
};
struct EpiK {
    static constexpr bool PERM = true, AFTER_DRAIN = false;
    bf16_t* KB;
    __device__ __forceinline__ void operator()(EPI_ARGS) const {
        FOR_AI_M {
            const size_t row = (size_t)(u.pm * 256 + ai * 128 + wr * 64 + m * 16 + fr);
#pragma unroll
            for (int bj = 0; bj < 2; ++bj) { const int c = u.pn * 256 + bj * 128 + wc * 32 + 8 * fq; *(u32x4*)(KB + row * 768 + (c >> 6) * 96 + (c & 63)) = pack8(acc[ai][bj][m][0], acc[ai][bj][m][1]); }
        }
    }
};
struct EpiStore {
    static constexpr bool PERM = true, AFTER_DRAIN = false;
    bf16_t* O; size_t ldc;
    __device__ __forceinline__ void operator()(EPI_ARGS) const {
        FOR_AI_M {
            const size_t row = (size_t)(u.pm * 256 + ai * 128 + wr * 64 + m * 16 + fr);
#pragma unroll
            for (int bj = 0; bj < 2; ++bj) { const int c = u.pn * 256 + bj * 128 + wc * 32 + 8 * fq; *(u32x4*)(O + row * ldc + c) = pack8(acc[ai][bj][m][0], acc[ai][bj][m][1]); }
        }
    }
};
template <bool ACCUM> struct EpiGate {
    static constexpr bool PERM = true, AFTER_DRAIN = false;
    bf16_t* M1; const bf16_t* G; int goff;
    __device__ __forceinline__ void operator()(EPI_ARGS) const {
        FOR_AI_M {
            const size_t row = (size_t)(u.pm * 256 + ai * 128 + wr * 64 + m * 16 + fr);
#pragma unroll
            for (int bj = 0; bj < 2; ++bj) { const int c = u.pn * 256 + bj * 128 + wc * 32 + 8 * fq;
                f32x4 g0, g1; unpack8(*(const u32x4*)(G + row * 2048 + goff + c), g0, g1);
                f32x4 v0 = acc[ai][bj][m][0] * g0, v1 = acc[ai][bj][m][1] * g1;
                if (ACCUM) { f32x4 o0, o1; unpack8(*(const u32x4*)(M1 + row * 1024 + c), o0, o1); v0 = v0 + o0; v1 = v1 + o1; }
                *(u32x4*)(M1 + row * 1024 + c) = pack8(v0, v1); }
            if (m & 1) MEMFENCE;
        }
    }
};
struct EpiRes {
    static constexpr bool PERM = true, AFTER_DRAIN = false;
    const float* base_p; const float* base_s; float* X; bf16_t* XB; float* slots;
    __device__ __forceinline__ void operator()(EPI_ARGS) const {
        FOR_AI_M {
            const int row = u.pm * 256 + ai * 128 + wr * 64 + m * 16 + fr;
            const float* bs = row < MP ? base_p + (size_t)row * 1024 : base_s + (size_t)(row - MP) * 1024;
            float ss = 0.f;
#pragma unroll
            for (int bj = 0; bj < 2; ++bj) { const int c = u.pn * 256 + bj * 128 + wc * 32 + 8 * fq;
                const f32x4 v0 = acc[ai][bj][m][0] + *(const f32x4*)(bs + c), v1 = acc[ai][bj][m][1] + *(const f32x4*)(bs + c + 4);
                *(f32x4*)(X + (size_t)row * 1024 + c) = v0; *(f32x4*)(X + (size_t)row * 1024 + c + 4) = v1;
                *(u32x4*)(XB + (size_t)row * 1024 + c) = pack8(v0, v1);
                ss += (v0[0] * v0[0] + v0[1] * v0[1]) + (v0[2] * v0[2] + v0[3] * v0[3]) + (v1[0] * v1[0] + v1[1] * v1[1]) + (v1[2] * v1[2] + v1[3] * v1[3]); }
            ss += __shfl_xor(ss, 16); ss += __shfl_xor(ss, 32);
            if (fq == 0) slots[(size_t)row * 16 + u.pn * 4 + wc] = ss;
            if (m & 1) MEMFENCE;
        }
    }
};
struct EpiUp {
    static constexpr bool PERM = true, AFTER_DRAIN = false;
    bf16_t* H; const float* slots;
    __device__ __forceinline__ void operator()(EPI_ARGS) const {
        FOR_AI_M {
            const size_t row = (size_t)(u.pm * 256 + ai * 128 + wr * 64 + m * 16 + fr);
            const float rs = rs_from_slots(slots + row * 16, 1.0f / 1024.0f, RMS_EPS);
#pragma unroll
            for (int bj = 0; bj < 2; ++bj) { const int c = u.pn * 256 + bj * 128 + wc * 32 + 8 * fq;
                f32x4 v0 = acc[ai][bj][m][0] * rs, v1 = acc[ai][bj][m][1] * rs;
#pragma unroll
                for (int k = 0; k < 4; ++k) { const float a = fmaxf(v0[k], 0.f), b = fmaxf(v1[k], 0.f); v0[k] = a * a; v1[k] = b * b; }
                *(u32x4*)(H + row * 4096 + c) = pack8(v0, v1); }
            if (m & 1) MEMFENCE;
        }
    }
};
struct EpiPle {
    static constexpr bool PERM = true, AFTER_DRAIN = false;
    float* X; const bf16_t* PP; const float* slots2; float* slots3;
    __device__ __forceinline__ void operator()(EPI_ARGS) const {
        FOR_AI_M {
            const size_t row = (size_t)(u.pm * 256 + ai * 128 + wr * 64 + m * 16 + fr);
            const float rs = rs_from_slots(slots2 + row * 16, 1.0f / 1024.0f, RMS_EPS);
            float ss = 0.f;
#pragma unroll
            for (int bj = 0; bj < 2; ++bj) { const int c = u.pn * 256 + bj * 128 + wc * 32 + 8 * fq;
                f32x4 p0, p1; unpack8(*(const u32x4*)(PP + row * 1024 + c), p0, p1);
                f32x4 v0 = *(const f32x4*)(X + row * 1024 + c), v1 = *(const f32x4*)(X + row * 1024 + c + 4);
#pragma unroll
                for (int k = 0; k < 4; ++k) { v0[k] += sigmoidf_(acc[ai][bj][m][0][k] * rs) * p0[k]; v1[k] += sigmoidf_(acc[ai][bj][m][1][k] * rs) * p1[k]; }
                *(f32x4*)(X + row * 1024 + c) = v0; *(f32x4*)(X + row * 1024 + c + 4) = v1;
                ss += (v0[0] * v0[0] + v0[1] * v0[1]) + (v0[2] * v0[2] + v0[3] * v0[3]) + (v1[0] * v1[0] + v1[1] * v1[1]) + (v1[2] * v1[2] + v1[3] * v1[3]); }
            ss += __shfl_xor(ss, 16); ss += __shfl_xor(ss, 32);
            if (fq == 0) slots3[row * 16 + u.pn * 4 + wc] = ss;
            MEMFENCE;
        }
    }
};

struct EpiAtomic {
    static constexpr bool PERM = true, AFTER_DRAIN = false;
    float* X;
    __device__ __forceinline__ void operator()(EPI_ARGS) const {
        FOR_AI_M {
            const size_t row = (size_t)(u.pm * 256 + ai * 128 + wr * 64 + m * 16 + fr);
#pragma unroll
            for (int bj = 0; bj < 2; ++bj) { const int c = u.pn * 256 + bj * 128 + wc * 32 + 8 * fq; float* d = X + row * 1024 + c;
#pragma unroll
                for (int k = 0; k < 4; ++k) { (void)__hip_atomic_fetch_add(d + k, acc[ai][bj][m][0][k], __ATOMIC_RELAXED, __HIP_MEMORY_SCOPE_AGENT); (void)__hip_atomic_fetch_add(d + 4 + k, acc[ai][bj][m][1][k], __ATOMIC_RELAXED, __HIP_MEMORY_SCOPE_AGENT); } }
        }
    }
};
struct OneUnit {
    int pm, pn;
    __device__ __forceinline__ bool next(int i, Unit& u) const { if (i != 0) return false; u.pm = pm; u.pn = pn; return true; }
    __device__ __forceinline__ void a_ready(const Unit&) const {}
    __device__ __forceinline__ void done(const Unit&) const {}
};
__device__ __forceinline__ void phase_sample_post(const Params& p) {
    const int lane = threadIdx.x & 63, gw = blockIdx.x * 8 + (threadIdx.x >> 6), NGW = gridDim.x * 8;
    bf16_t* XB = (bf16_t*)(p.ws + WS_XN); float* slots = (float*)(p.ws + WS_SLOT2);
    for (int r = gw; r < MS; r += NGW) {
        const size_t row = (size_t)MP + r; const float* x = p.out + OUT_Y + row * 1024; float s = 0.f;
#pragma unroll
        for (int j = 0; j < 4; ++j) { const f32x4 v = *(const f32x4*)(x + 4 * lane + 256 * j); s += (v[0] * v[0] + v[1] * v[1]) + (v[2] * v[2] + v[3] * v[3]);
            u32x2 w; w.x = pk2(v[0], v[1]); w.y = pk2(v[2], v[3]); *(u32x2*)(XB + row * 1024 + 4 * lane + 256 * j) = w; }
        s = wave_sum(s);
        if (lane < 16) slots[row * 16 + lane] = lane == 0 ? s : 0.f;
    }
}
template <class Epi> __device__ __forceinline__ void run_gemm(LAS unsigned char* lds, const bf16_t* A, const bf16_t* Bt, int M, int N, int K, const Epi& E, int rot = 0, int lda = 0) {
    asm volatile("" : "+s"(K));
    pg8::Gemm g{A, Bt, M, N, K, lda ? lda : K, K}; pg8::StaticOrder S; S.init(M, N, (int)gridDim.x, (int)((blockIdx.x + rot) % gridDim.x));
    pg8::gemm_phase<Epi, pg8::StaticOrder, true, true>(lds, g, S, E);
}

__device__ __forceinline__ void tr_item(const float* W, int ldw, int K, bf16_t* WT, int src_c0, int dst_r0, int k0, const float* ksc, LAS float* scr, int lane) {
    float tv[32];
#pragma unroll
    for (int i = 0; i < 32; ++i) { const int kk = 2 * i + (lane >> 5); tv[i] = 0.f;
        if (src_c0 >= 0) { tv[i] = W[(size_t)(k0 + kk) * ldw + src_c0 + (lane & 31)]; if (ksc) tv[i] *= ksc[k0 + kk]; } }
#pragma unroll
    for (int i = 0; i < 32; ++i) { const int kk = 2 * i + (lane >> 5); scr[kk * 33 + (lane & 31)] = tv[i]; }
    asm volatile("s_waitcnt lgkmcnt(0)" ::: "memory");
    const int c = lane & 7;
#pragma unroll
    for (int j = 0; j < 4; ++j) { const int n = (lane >> 3) + 8 * j; const LAS float* s = scr + (8 * c) * 33 + n;
        u32x4 o; o.x = pk2(s[0 * 33], s[1 * 33]); o.y = pk2(s[2 * 33], s[3 * 33]); o.z = pk2(s[4 * 33], s[5 * 33]); o.w = pk2(s[6 * 33], s[7 * 33]);
        *(u32x4*)(WT + (size_t)(dst_r0 + n) * K + k0 + 8 * c) = o; }
    asm volatile("s_waitcnt lgkmcnt(0)" ::: "memory");
}
__device__ __forceinline__ int win_src_col(int n) {
    if (n < 1056) return n;
    if (n < 1280) return -1;
    if (n < 2304) { const int q = n - 1280, i = q >> 8, j = q & 255; return j < 128 ? 1056 + 128 * i + j : 1056 + 512 + 128 * i + (j - 128); }
    return 2080 + (n - 2304);
}
__device__ __forceinline__ bool tr_mat(int& r, const float* W, int K, int N, bf16_t* WT, const float* ksc, LAS float* scr, int lane) {
    const int nblk = N / 32, items = (K / 64) * nblk;
    if (r >= items) { r -= items; return false; }
    const int kb = r / nblk, nb = r % nblk;
    tr_item(W, N, K, WT, 32 * nb, 32 * nb, 64 * kb, ksc, scr, lane);
    return true;
}
constexpr int W_I_WIN = 16 * (NZ / 32);
constexpr int W_ITEMS_EARLY = W_I_WIN + 12 * 24 + 4 * 16 * 2 + 8 * 32 * 2 + 16 * 32;
constexpr int W_ITEMS_UP = W_ITEMS_EARLY + 16 * 128;
constexpr int W_ITEMS_ALL = W_ITEMS_UP + 64 * 32 + 16 * 32 + 4 * 32;
__device__ __forceinline__ void tr_range(const Params& p, LAS unsigned char* lds, int lo, int hi, int vb, int vg) {
    const int tid = threadIdx.x, lane = tid & 63, wave = tid >> 6;
    const int gw = vb * 8 + wave, NGW = vg * 8;
    unsigned char* ws = p.ws;
    LAS float* scr = (LAS float*)(lds + wave * 16384);
    constexpr int I_WIN = W_I_WIN;
    for (int it = lo + gw; it < hi; it += NGW) {
        int r = it;
        if (r < I_WIN) { const int nblk = NZ / 32, kb = r / nblk, nb = r % nblk; tr_item(p.in[8], IN_W, 1024, (bf16_t*)(ws + WS_WIN), win_src_col(32 * nb), 32 * nb, 64 * kb, nullptr, scr, lane); continue; }
        r -= I_WIN;
        if (tr_mat(r, p.in[10], QL, 768, (bf16_t*)(ws + WS_WUQ), p.in[9], scr, lane)) continue;
        if (tr_mat(r, p.in[12], 256, 512, (bf16_t*)(ws + WS_WUK), nullptr, scr, lane)) continue;
        if (tr_mat(r, p.in[13], 256, 512, (bf16_t*)(ws + WS_WUV), nullptr, scr, lane)) continue;
        if (tr_mat(r, p.in[14], 512, 1024, (bf16_t*)(ws + WS_WAO), nullptr, scr, lane)) continue;
        if (tr_mat(r, p.in[19], 512, 1024, (bf16_t*)(ws + WS_WCO), nullptr, scr, lane)) continue;
        if (tr_mat(r, p.in[20], 1024, 1024, (bf16_t*)(ws + WS_WOUT), nullptr, scr, lane)) continue;
        if (tr_mat(r, p.in[22], 1024, 4096, (bf16_t*)(ws + WS_WUP), p.in[21], scr, lane)) continue;
        if (tr_mat(r, p.in[23], 4096, 1024, (bf16_t*)(ws + WS_WDN), nullptr, scr, lane)) continue;
        if (tr_mat(r, p.in[25], 1024, 1024, (bf16_t*)(ws + WS_WPG), p.in[24], scr, lane)) continue;
        tr_mat(r, p.in[26], 256, 1024, (bf16_t*)(ws + WS_WPP), nullptr, scr, lane);
    }
}
__device__ __forceinline__ void phase0(const Params& p, LAS unsigned char* lds) {
    const int tid = threadIdx.x, lane = tid & 63, wave = tid >> 6;
    const int gw = blockIdx.x * 8 + wave, NGW = gridDim.x * 8;
    const size_t gt = (size_t)blockIdx.x * 512 + tid, NGT = (size_t)gridDim.x * 512;
    unsigned char* ws = p.ws;
    LAS float* scr = (LAS float*)(lds + wave * 16384);
    tr_range(p, lds, 0, W_ITEMS_EARLY, (int)blockIdx.x, (int)gridDim.x);
    {
        const float* g = p.in[7]; bf16_t* XN = (bf16_t*)(ws + WS_XN);
        f32x4 gv[4];
#pragma unroll
        for (int j = 0; j < 4; ++j) gv[j] = *(const f32x4*)(g + 4 * lane + 256 * j);
        for (int row = gw; row < MT; row += 2 * NGW) {
            const int rowb = row + NGW; const bool vb = rowb < MT; const int rb = vb ? rowb : row;
            const float* xr = row < MP ? p.in[0] + (size_t)row * 1024 : p.in[1] + (size_t)(row - MP) * 1024;
            const float* xq = rb < MP ? p.in[0] + (size_t)rb * 1024 : p.in[1] + (size_t)(rb - MP) * 1024;
            f32x4 v[4], u[4]; float s = 0.f, t = 0.f;
#pragma unroll
            for (int j = 0; j < 4; ++j) { v[j] = *(const f32x4*)(xr + 4 * lane + 256 * j); u[j] = *(const f32x4*)(xq + 4 * lane + 256 * j); }
#pragma unroll
            for (int j = 0; j < 4; ++j) { s += (v[j][0] * v[j][0] + v[j][1] * v[j][1]) + (v[j][2] * v[j][2] + v[j][3] * v[j][3]); t += (u[j][0] * u[j][0] + u[j][1] * u[j][1]) + (u[j][2] * u[j][2] + u[j][3] * u[j][3]); }
            const float rs = 1.0f / sqrtf(wave_sum(s) * (1.0f / 1024.0f) + RMS_EPS), rt = 1.0f / sqrtf(wave_sum(t) * (1.0f / 1024.0f) + RMS_EPS);
#pragma unroll
            for (int j = 0; j < 4; ++j) { const f32x4 o = v[j] * rs * gv[j]; u32x2 w; w.x = pk2(o[0], o[1]); w.y = pk2(o[2], o[3]); *(u32x2*)(XN + (size_t)row * 1024 + 4 * lane + 256 * j) = w; }
            if (vb) {
#pragma unroll
                for (int j = 0; j < 4; ++j) { const f32x4 o = u[j] * rt * gv[j]; u32x2 w; w.x = pk2(o[0], o[1]); w.y = pk2(o[2], o[3]); *(u32x2*)(XN + (size_t)rowb * 1024 + 4 * lane + 256 * j) = w; }
            }
        }
    }
    {
        float* R = (float*)(ws + WS_ROPE);
        for (size_t e = gt; e < (size_t)KVSEQ * 16; e += NGT) {
            const int pos = (int)(e >> 4), i = (int)(e & 15);
            const float inv = exp2f(-(float)i * (13.287712379549449f / 16.0f));
            const float ang = (float)pos * inv;
            R[2 * e] = cosf(ang); R[2 * e + 1] = sinf(ang);
        }
    }
}

__device__ __forceinline__ void phase_cache(const Params& p, int vb, int vg) {
    const size_t gt = (size_t)vb * 512 + threadIdx.x, NGT = (size_t)vg * 512;
    unsigned char* ws = p.ws;
    {
        const float* src = p.in[4]; bf16_t* L = (bf16_t*)(ws + WS_LATKV);
        for (size_t e0 = gt; e0 < (size_t)32 * PAST * 32; e0 += 4 * NGT) {
            f32x4 a[4], bb[4];
#pragma unroll
            for (int i = 0; i < 4; ++i) { const size_t e = e0 + i * NGT; if (e < (size_t)32 * PAST * 32) { a[i] = *(const f32x4*)(src + e * 8); bb[i] = *(const f32x4*)(src + e * 8 + 4); } }
#pragma unroll
            for (int i = 0; i < 4; ++i) { const size_t e = e0 + i * NGT; if (e < (size_t)32 * PAST * 32) {
                const size_t row = e >> 5; const int c8 = (int)(e & 31); const int b = (int)(row >> 12), k = (int)(row & 4095);
                *(u32x4*)(L + (size_t)(MP + b * KVSEQ + k) * 256 + c8 * 8) = pack8(a[i], bb[i]); } }
        }
    }
    {
        const float* src = p.in[5]; bf16_t* KB = (bf16_t*)(ws + WS_KB);
        for (size_t e = gt; e < (size_t)32 * PAST * 4; e += NGT) {
            const size_t row = e >> 2; const int c8 = (int)(e & 3); const int b = (int)(row >> 12), k = (int)(row & 4095);
            const f32x4 a = *(const f32x4*)(src + row * 32 + c8 * 8), bb = *(const f32x4*)(src + row * 32 + c8 * 8 + 4);
            const u32x4 w = pack8(a, bb); bf16_t* d = KB + (size_t)(MP + b * KVSEQ + k) * 768 + 64 + c8 * 8;
#pragma unroll
            for (int h = 0; h < 8; ++h) *(u32x4*)(d + h * 96) = w;
        }
    }
}
__device__ __forceinline__ void phase_pbf(const Params& p, int vb, int vg) {
    const size_t gt = (size_t)vb * 512 + threadIdx.x, NGT = (size_t)vg * 512;
    bf16_t* P = (bf16_t*)(p.ws + WS_PBF);
    for (size_t e = gt; e < (size_t)MT * 32; e += NGT) {
        const float* s = e < (size_t)MP * 32 ? p.in[2] + e * 8 : p.in[3] + (e - (size_t)MP * 32) * 8;
        *(u32x4*)(P + e * 8) = pack8(*(const f32x4*)s, *(const f32x4*)(s + 4));
    }
}
struct TokIn { u32x4 kv, kr; f32x4 t0, t1, t2, t3; };
__device__ __forceinline__ TokIn tok_load(const bf16_t* Zs, const float* rope, int row, int lane) {
    TokIn r; const bf16_t* z = Zs + (size_t)row * ZW;
    r.kv = (u32x4){0u, 0u, 0u, 0u}; r.kr = r.kv; r.t0 = (f32x4){0.f, 0.f, 0.f, 0.f}; r.t1 = r.t0; r.t2 = r.t0; r.t3 = r.t0;
    if (lane < 32) r.kv = *(const u32x4*)(z + 768 + 8 * lane);
    if (lane < 4) { r.kr = *(const u32x4*)(z + 1024 + 8 * lane);
        const float* cs = rope + ((size_t)pos_of_row(row) * 16 + 8 * (lane & 1)) * 2;
        r.t0 = *(const f32x4*)cs; r.t1 = *(const f32x4*)(cs + 4); r.t2 = *(const f32x4*)(cs + 8); r.t3 = *(const f32x4*)(cs + 12); }
    return r;
}
__device__ __forceinline__ void tok_proc(const Params& p, const TokIn& in, int row, int lane, bf16_t* L, bf16_t* KB, const f32x4& kg0, const f32x4& kg1) {
    const int kvrow = kvrow_of_row(row);
    f32x4 b0, b1; unpack8(in.kv, b0, b1);
    const float s = (b0[0] * b0[0] + b0[1] * b0[1]) + (b0[2] * b0[2] + b0[3] * b0[3]) + (b1[0] * b1[0] + b1[1] * b1[1]) + (b1[2] * b1[2] + b1[3] * b1[3]);
    const float rk = 1.0f / sqrtf(wave_sum(s) * (1.0f / 256.0f) + RMS_EPS);
    if (lane < 32) {
        const f32x4 l0 = b0 * rk * kg0, l1 = b1 * rk * kg1;
        float* o = row < MP ? p.out + OUT_LATP + (size_t)row * 256 : p.out + OUT_LATS + (size_t)(row - MP) * 256;
        *(f32x4*)(o + 8 * lane) = l0; *(f32x4*)(o + 8 * lane + 4) = l1;
        *(u32x4*)(L + (size_t)kvrow * 256 + 8 * lane) = pack8(l0, l1);
    }
    f32x4 c0, c1; unpack8(in.kr, c0, c1);
    f32x4 d0, d1;
#pragma unroll
    for (int k = 0; k < 4; ++k) { d0[k] = __shfl_xor(c0[k], 2); d1[k] = __shfl_xor(c1[k], 2); }
    if (lane < 4) {
        const f32x4 cc0 = {in.t0[0], in.t0[2], in.t1[0], in.t1[2]}, ss0 = {in.t0[1], in.t0[3], in.t1[1], in.t1[3]}, cc1 = {in.t2[0], in.t2[2], in.t3[0], in.t3[2]}, ss1 = {in.t2[1], in.t2[3], in.t3[1], in.t3[3]};
        f32x4 o0, o1;
        if (lane < 2) { o0 = c0 * cc0 - d0 * ss0; o1 = c1 * cc1 - d1 * ss1; }
        else { o0 = c0 * cc0 + d0 * ss0; o1 = c1 * cc1 + d1 * ss1; }
        float* o = row < MP ? p.out + OUT_KRP + (size_t)row * 32 : p.out + OUT_KRS + (size_t)(row - MP) * 32;
        *(f32x4*)(o + 8 * lane) = o0; *(f32x4*)(o + 8 * lane + 4) = o1;
        const u32x4 w = pack8(o0, o1); bf16_t* d = KB + (size_t)kvrow * 768 + 64 + 8 * lane;
#pragma unroll
        for (int h = 0; h < 8; ++h) *(u32x4*)(d + h * 96) = w;
    }
}
__device__ __forceinline__ void phase_mid_tokens(const Params& p) {
    const int tid = threadIdx.x, lane = tid & 63, wave = tid >> 6;
    const int gw = blockIdx.x * 8 + wave, NGW = gridDim.x * 8;
    unsigned char* ws = p.ws;
    const bf16_t* Zs = (const bf16_t*)(ws + WS_ZS); bf16_t* L = (bf16_t*)(ws + WS_LATKV); bf16_t* KB = (bf16_t*)(ws + WS_KB);
    const float* rope = (const float*)(ws + WS_ROPE);
    const float* kg = p.in[11];
    f32x4 kg0 = {1.f, 1.f, 1.f, 1.f}, kg1 = kg0;
    if (lane < 32) { kg0 = *(const f32x4*)(kg + 8 * lane); kg1 = *(const f32x4*)(kg + 8 * lane + 4); }
    for (int row = gw; row < MT; row += 4 * NGW) {
        const int r1 = row + NGW, r2 = row + 2 * NGW, r3 = row + 3 * NGW; const bool v1 = r1 < MT, v2 = r2 < MT, v3 = r3 < MT;
        const TokIn A = tok_load(Zs, rope, row, lane), B = tok_load(Zs, rope, v1 ? r1 : row, lane), C = tok_load(Zs, rope, v2 ? r2 : row, lane), D = tok_load(Zs, rope, v3 ? r3 : row, lane);
        tok_proc(p, A, row, lane, L, KB, kg0, kg1);
        if (v1) tok_proc(p, B, r1, lane, L, KB, kg0, kg1);
        if (v2) tok_proc(p, C, r2, lane, L, KB, kg0, kg1);
        if (v3) tok_proc(p, D, r3, lane, L, KB, kg0, kg1);
    }
}
__device__ __forceinline__ void phase_mid_conv(const Params& p, LAS unsigned char* lds) {
    const int tid = threadIdx.x, lane = tid & 63, wave = tid >> 6;
    unsigned char* ws = p.ws;
    const bf16_t* U = (const bf16_t*)(ws + WS_U); bf16_t* CACT = (bf16_t*)(ws + WS_CACT);
    LAS unsigned* ut = (LAS unsigned*)lds;
    LAS float* dwb = (LAS float*)(lds + 62 * 1024);
    const int cp = tid & 255, half = tid >> 8;
    f32x2_t w[31];
#pragma unroll
    for (int j = 0; j < 31; ++j) w[j] = *(const f32x2_t*)(p.in[15] + j * 512 + 2 * cp);
    const f32x2_t cb = *(const f32x2_t*)(p.in[16] + 2 * cp);
    const f32x4 lg0 = *(const f32x4*)(p.in[17] + 8 * lane), lg1 = *(const f32x4*)(p.in[17] + 8 * lane + 4), lb0 = *(const f32x4*)(p.in[18] + 8 * lane), lb1 = *(const f32x4*)(p.in[18] + 8 * lane + 4);
    constexpr int NBLK = MP / 32 + 32;
    u32x4 stg[8];
#define CONV_LOAD(cbk_) do { const int cbk__ = (cbk_); const bool pr_ = cbk__ < MP / 32; const int sb_ = cbk__ - MP / 32; \
        const int t0_ = pr_ ? (cbk__ & 127) * 32 : 0, R_ = pr_ ? 32 : 16, row0_ = pr_ ? cbk__ * 32 : MP + sb_ * 16; \
        _Pragma("unroll") for (int i_ = 0; i_ < 8; ++i_) { const int ch_ = tid + 512 * i_, rr_ = ch_ >> 6, c8_ = ch_ & 63, t_ = t0_ - 30 + rr_; \
            u32x4 w_ = {0u, 0u, 0u, 0u}; \
            if (rr_ < 30 + R_) { if (t_ >= 0) w_ = *(const u32x4*)(U + (size_t)(row0_ + rr_ - 30) * 512 + c8_ * 8); \
                else if (!pr_) { const float* hs_ = p.in[6] + ((size_t)sb_ * 30 + rr_) * 512 + c8_ * 8; w_ = pack8(*(const f32x4*)hs_, *(const f32x4*)(hs_ + 4)); } } \
            stg[i_] = w_; } } while (0)
    if ((int)blockIdx.x < NBLK) CONV_LOAD(blockIdx.x);
    for (int cbk = blockIdx.x; cbk < NBLK; cbk += gridDim.x) {
        const bool prompt = cbk < MP / 32;
        const int sb = cbk - MP / 32;
        const int R = prompt ? 32 : 16;
        const int row0 = prompt ? cbk * 32 : MP + sb * 16;
#pragma unroll
        for (int i = 0; i < 8; ++i) { const int ch = tid + 512 * i, rr = ch >> 6, c8 = ch & 63; if (rr < 62) *(LAS u32x4*)(ut + rr * 256 + c8 * 4) = stg[i]; }
        __syncthreads();
        if (cbk + (int)gridDim.x < NBLK) CONV_LOAD(cbk + gridDim.x);
        if (half * 16 < R) {
#pragma unroll 1
            for (int hh = 0; hh < 2; ++hh) {
                const int tb = half * 16 + hh * 8;
                f32x2_t uu[38];
#pragma unroll
                for (int r = 0; r < 38; ++r) { const unsigned x = ut[(tb + r) * 256 + cp]; uu[r] = (f32x2_t){bflo(x), bfhi(x)}; }
#pragma unroll
                for (int tt = 0; tt < 8; ++tt) {
                    f32x2_t a = cb;
#pragma unroll
                    for (int j = 0; j < 31; ++j) a = __builtin_elementwise_fma(w[j], uu[tt + j], a);
                    *(LAS f32x2_t*)(dwb + (tb + tt) * 512 + 2 * cp) = a;
                }
            }
        }
        __syncthreads();
#pragma unroll
        for (int i = 0; i < 4; ++i) {
            const int tl = wave * 4 + i;
            if (tl < R) {
                const f32x4 v0 = *(const LAS f32x4*)(dwb + tl * 512 + 8 * lane), v1 = *(const LAS f32x4*)(dwb + tl * 512 + 8 * lane + 4);
                const float mean = wave_sum((v0[0] + v0[1]) + (v0[2] + v0[3]) + (v1[0] + v1[1]) + (v1[2] + v1[3])) * (1.0f / 512.0f);
                const f32x4 e0 = v0 - mean, e1 = v1 - mean;
                const float var = wave_sum((e0[0] * e0[0] + e0[1] * e0[1]) + (e0[2] * e0[2] + e0[3] * e0[3]) + (e1[0] * e1[0] + e1[1] * e1[1]) + (e1[2] * e1[2] + e1[3] * e1[3])) * (1.0f / 512.0f);
                const float rstd = 1.0f / sqrtf(var + LN_EPS);
                f32x4 y0 = e0 * rstd * lg0 + lb0, y1 = e1 * rstd * lg1 + lb1;
#pragma unroll
                for (int k = 0; k < 4; ++k) { y0[k] = y0[k] * sigmoidf_(y0[k]); y1[k] = y1[k] * sigmoidf_(y1[k]); }
                *(u32x4*)(CACT + (size_t)(row0 + tl) * 512 + 8 * lane) = pack8(y0, y1);
            }
        }
        __syncthreads();
    }
#undef CONV_LOAD
    {
        const size_t gt = (size_t)blockIdx.x * 512 + tid, NGT = (size_t)gridDim.x * 512;
        for (size_t e = gt; e < (size_t)(16 + 32) * 30 * 512; e += NGT) {
            if (e < (size_t)16 * 30 * 512) { const int b = (int)(e / (30 * 512)), i = (int)((e / 512) % 30), c = (int)(e & 511);
                p.out[OUT_CVP + e] = __uint_as_float((unsigned)U[(size_t)(b * TP + TP - 30 + i) * 512 + c] << 16); }
            else { const size_t f = e - (size_t)16 * 30 * 512; const int sbb = (int)(f / (30 * 512)), i = (int)((f / 512) % 30), c = (int)(f & 511);
                p.out[OUT_CVS + f] = i < 14 ? p.in[6][((size_t)sbb * 30 + 16 + i) * 512 + c] : __uint_as_float((unsigned)U[(size_t)(MP + sbb * 16 + i - 14) * 512 + c] << 16); }
        }
    }
}

constexpr int AK_PITCH = 208, AV_PITCH = 136, AK_BYTES = 64 * AK_PITCH, AV_BYTES = 64 * AV_PITCH, AV_OFF = 2 * AK_BYTES;
constexpr float ATT_THR = 6.0f;
__device__ __forceinline__ float rowmax32(const f32x16& a, const f32x16& b) {
    float m0 = __builtin_fmaxf(__builtin_fmaxf(a[0], a[1]), b[0]), m1 = __builtin_fmaxf(__builtin_fmaxf(a[2], a[3]), b[1]);
    m0 = __builtin_fmaxf(__builtin_fmaxf(m0, b[2]), b[3]);
#pragma unroll
    for (int r = 4; r < 16; r += 4) { m0 = __builtin_fmaxf(__builtin_fmaxf(m0, a[r]), a[r + 1]); m1 = __builtin_fmaxf(__builtin_fmaxf(m1, a[r + 2]), a[r + 3]);
        m0 = __builtin_fmaxf(__builtin_fmaxf(m0, b[r]), b[r + 1]); m1 = __builtin_fmaxf(__builtin_fmaxf(m1, b[r + 2]), b[r + 3]); }
    const float m = __builtin_fmaxf(m0, m1);
    auto rr = __builtin_amdgcn_permlane32_swap(__float_as_uint(m), __float_as_uint(m), false, false);
    return __builtin_fmaxf(__uint_as_float(rr[0]), __uint_as_float(rr[1]));
}
__device__ __forceinline__ void attn_unit(LAS unsigned char* lds, const bf16_t* QB, const bf16_t* KB, const bf16_t* VT, bf16_t* O,
                                          int qrow0, int nq_valid, int qpos0, int kvrow0, int ntiles, int kvlen, int h, bool causal) {
    const int tid = threadIdx.x, lane = tid & 63, ql = lane & 31, hi = lane >> 5;
    const int wid = __builtin_amdgcn_readfirstlane(tid >> 6);
    const bool wactive = 32 * wid < nq_valid;
    const int tlim = causal ? ((qpos0 + 32 * wid) >> 6) : (ntiles - 1);
    int qr = qrow0 + 32 * wid + ql; qr = qr < MT ? qr : MT - 1;
    const bf16_t* qp = QB + (size_t)qr * 768 + h * 96 + 8 * hi;
    bf16x8 qf[6];
#pragma unroll
    for (int j = 0; j < 6; ++j) qf[j] = *(const bf16x8*)(qp + 16 * j);
    const int kr0 = tid / 12, kc0 = tid % 12, kr1 = (tid + 512) / 12, kc1 = (tid + 512) % 12, vr = tid >> 3, vc = tid & 7;
    const bf16_t* kg0 = KB + (size_t)(kvrow0 + kr0) * 768 + h * 96 + kc0 * 8;
    const bf16_t* kg1 = KB + (size_t)(kvrow0 + kr1) * 768 + h * 96 + kc1 * 8;
    const bf16_t* vg = VT + (size_t)(h * 64 + vr) * VT_LD + kvrow0 + vc * 8;
    const int kl0 = kr0 * AK_PITCH + kc0 * 16, kl1 = kr1 * AK_PITCH + kc1 * 16, vl = AV_OFF + vr * AV_PITCH + vc * 16;
    u32x4 rk0, rk1 = {0u, 0u, 0u, 0u}, rv;
#define A_LOADK(t) do { rk0 = *(const u32x4*)(kg0 + (size_t)(t) * 64 * 768); if (tid < 256) rk1 = *(const u32x4*)(kg1 + (size_t)(t) * 64 * 768); } while (0)
#define A_LOADV(t) do { rv = *(const u32x4*)(vg + (t) * 64); } while (0)
#define A_STOREK(b) do { *(LAS u32x4*)(lds + (b) * AK_BYTES + kl0) = rk0; if (tid < 256) *(LAS u32x4*)(lds + (b) * AK_BYTES + kl1) = rk1; } while (0)
#define A_STOREV(b) do { *(LAS u32x2*)(lds + (b) * AV_BYTES + vl) = (u32x2){rv.x, rv.y}; *(LAS u32x2*)(lds + (b) * AV_BYTES + vl + 8) = (u32x2){rv.z, rv.w}; } while (0)
#define QK_TILE(S0, S1, buf) do { const LAS unsigned char* kb_ = lds + (buf) * AK_BYTES + ql * AK_PITCH + hi * 16; \
        _Pragma("unroll") for (int r_ = 0; r_ < 16; ++r_) { S0[r_] = -mref; S1[r_] = -mref; } \
        _Pragma("unroll") for (int j_ = 0; j_ < 6; ++j_) { \
            const bf16x8 ka_ = *(const LAS bf16x8*)(kb_ + j_ * 32), kb2_ = *(const LAS bf16x8*)(kb_ + 32 * AK_PITCH + j_ * 32); \
            S0 = __builtin_amdgcn_mfma_f32_32x32x16_bf16(ka_, qf[j_], S0, 0, 0, 0); S1 = __builtin_amdgcn_mfma_f32_32x32x16_bf16(kb2_, qf[j_], S1, 0, 0, 0); } } while (0)
#define KMASK(S0, S1, t) do { if ((t) * 64 + 64 > kvlen) { _Pragma("unroll") for (int r_ = 0; r_ < 16; ++r_) { const int key_ = (t) * 64 + (r_ & 3) + 8 * (r_ >> 2) + 4 * hi; \
        if (key_ >= kvlen) S0[r_] = -1e30f; if (key_ + 32 >= kvlen) S1[r_] = -1e30f; } } } while (0)
    float mref = 0.f, lrun = 0.f;
    f32x16 o0, o1, sc0, sc1, sn0, sn1;
#pragma unroll
    for (int r = 0; r < 16; ++r) { o0[r] = 0.f; o1[r] = 0.f; sc0[r] = 0.f; sc1[r] = 0.f; }
    A_LOADK(0); A_LOADV(0); A_STOREK(0); A_STOREV(0);
    __syncthreads();
    if (ntiles > 1) A_LOADK(1);
    if (wactive) {
        QK_TILE(sc0, sc1, 0); KMASK(sc0, sc1, 0);
        const float mx = rowmax32(sc0, sc1); mref = mx;
#pragma unroll
        for (int r = 0; r < 16; ++r) { sc0[r] -= mx; sc1[r] -= mx; }
    }
    if (ntiles > 1) A_STOREK(1);
    __syncthreads();
    for (int t = 0; t < ntiles; ++t) {
        if (t + 2 < ntiles) A_LOADK(t + 2);
        if (t + 1 < ntiles) A_LOADV(t + 1);
        if (wactive && t <= tlim) {
            bf16x8 kf[12];
            const LAS unsigned char* kbq = lds + ((t + 1) & 1) * AK_BYTES + ql * AK_PITCH + hi * 16;
            { const LAS unsigned char* kb_ = lds + ((t + 1) & 1) * AK_BYTES + ql * AK_PITCH + hi * 16;
#pragma unroll
              for (int j = 0; j < 4; ++j) { kf[2 * j] = *(const LAS bf16x8*)(kb_ + j * 32); kf[2 * j + 1] = *(const LAS bf16x8*)(kb_ + 32 * AK_PITCH + j * 32); }
            }
            __builtin_amdgcn_sched_barrier(0);
            if (t > 0) {
                KMASK(sc0, sc1, t);
                const float mx = rowmax32(sc0, sc1);
                if (__builtin_expect(__any(mx > ATT_THR), 0)) {
                    const float dl = __builtin_fmaxf(mx, 0.f), f = __builtin_amdgcn_exp2f(-dl);
                    mref += dl; lrun *= f;
#pragma unroll
                    for (int r = 0; r < 16; ++r) { sc0[r] -= dl; sc1[r] -= dl; o0[r] *= f; o1[r] *= f; }
                }
            }
#pragma unroll
            for (int r = 0; r < 16; ++r) { sn0[r] = -mref; sn1[r] = -mref; }
#pragma unroll
            for (int j = 4; j < 6; ++j) { kf[2 * j] = *(const LAS bf16x8*)(kbq + j * 32); kf[2 * j + 1] = *(const LAS bf16x8*)(kbq + 32 * AK_PITCH + j * 32); }
#pragma unroll
            for (int j = 0; j < 6; ++j) { sn0 = __builtin_amdgcn_mfma_f32_32x32x16_bf16(kf[2 * j], qf[j], sn0, 0, 0, 0); sn1 = __builtin_amdgcn_mfma_f32_32x32x16_bf16(kf[2 * j + 1], qf[j], sn1, 0, 0, 0); }
            float ls = 0.f;
#pragma unroll
            for (int r = 0; r < 16; ++r) { sc0[r] = __builtin_amdgcn_exp2f(sc0[r]); sc1[r] = __builtin_amdgcn_exp2f(sc1[r]); ls += sc0[r] + sc1[r]; }
            lrun += ls;
            bf16x8 pf[4];
#pragma unroll
            for (int jp = 0; jp < 2; ++jp) {
                u32x4 w; w.x = pk2(sc0[8 * jp + 0], sc0[8 * jp + 1]); w.y = pk2(sc0[8 * jp + 2], sc0[8 * jp + 3]); w.z = pk2(sc0[8 * jp + 4], sc0[8 * jp + 5]); w.w = pk2(sc0[8 * jp + 6], sc0[8 * jp + 7]);
                pf[jp] = __builtin_bit_cast(bf16x8, w);
                u32x4 x; x.x = pk2(sc1[8 * jp + 0], sc1[8 * jp + 1]); x.y = pk2(sc1[8 * jp + 2], sc1[8 * jp + 3]); x.z = pk2(sc1[8 * jp + 4], sc1[8 * jp + 5]); x.w = pk2(sc1[8 * jp + 6], sc1[8 * jp + 7]);
                pf[2 + jp] = __builtin_bit_cast(bf16x8, x);
            }
            __builtin_amdgcn_sched_barrier(0);
            u32x2 vf[16];
            { const LAS unsigned char* vb_ = lds + AV_OFF + (t & 1) * AV_BYTES + ql * AV_PITCH + hi * 8;
#pragma unroll
              for (int jp = 0; jp < 4; ++jp) { vf[4 * jp] = *(const LAS u32x2*)(vb_ + jp * 32); vf[4 * jp + 1] = *(const LAS u32x2*)(vb_ + jp * 32 + 16);
                  vf[4 * jp + 2] = *(const LAS u32x2*)(vb_ + 32 * AV_PITCH + jp * 32); vf[4 * jp + 3] = *(const LAS u32x2*)(vb_ + 32 * AV_PITCH + jp * 32 + 16); } }
#pragma unroll
            for (int jp = 0; jp < 4; ++jp) {
                const u32x2 a0 = vf[4 * jp], a1 = vf[4 * jp + 1], c0 = vf[4 * jp + 2], c1 = vf[4 * jp + 3];
                const bf16x8 va = __builtin_bit_cast(bf16x8, (u32x4){a0.x, a0.y, a1.x, a1.y}), vc2 = __builtin_bit_cast(bf16x8, (u32x4){c0.x, c0.y, c1.x, c1.y});
                o0 = __builtin_amdgcn_mfma_f32_32x32x16_bf16(va, pf[jp], o0, 0, 0, 0);
                o1 = __builtin_amdgcn_mfma_f32_32x32x16_bf16(vc2, pf[jp], o1, 0, 0, 0);
            }
            sc0 = sn0; sc1 = sn1;
        }
        if (t + 2 < ntiles) A_STOREK(t & 1);
        if (t + 1 < ntiles) A_STOREV((t + 1) & 1);
        __syncthreads();
    }
#undef A_LOADK
#undef A_LOADV
#undef A_STOREK
#undef A_STOREV
#undef QK_TILE
#undef KMASK
    float lt;
    { auto rr = __builtin_amdgcn_permlane32_swap(__float_as_uint(lrun), __float_as_uint(lrun), false, false); lt = __uint_as_float(rr[0]) + __uint_as_float(rr[1]); }
    if (wactive && (32 * wid + ql) < nq_valid) {
        const float inv = 1.0f / lt;
        bf16_t* op = O + (size_t)(qrow0 + 32 * wid + ql) * 512 + h * 64 + 4 * hi;
#pragma unroll
        for (int g = 0; g < 4; ++g) {
            u32x2 w0, w1; w0.x = pk2(o0[4 * g] * inv, o0[4 * g + 1] * inv); w0.y = pk2(o0[4 * g + 2] * inv, o0[4 * g + 3] * inv);
            w1.x = pk2(o1[4 * g] * inv, o1[4 * g + 1] * inv); w1.y = pk2(o1[4 * g + 2] * inv, o1[4 * g + 3] * inv);
            *(u32x2*)(op + 8 * g) = w0; *(u32x2*)(op + 32 + 8 * g) = w1;
        }
    }
}
__device__ __forceinline__ void phase_attn(const Params& p, LAS unsigned char* lds) {
    unsigned char* ws = p.ws;
    const bf16_t* QB = (const bf16_t*)(ws + WS_QB); const bf16_t* KB = (const bf16_t*)(ws + WS_KB); const bf16_t* VT = (const bf16_t*)(ws + WS_VT); bf16_t* O = (bf16_t*)(ws + WS_O);
    const bool swz = (gridDim.x == 256);
    for (int v0 = blockIdx.x; v0 < 256; v0 += gridDim.x) {
        const int v = swz ? ((v0 & 7) * 32 + (v0 >> 3)) : v0;
        const int bh = v >> 1, par = v & 1, b = bh >> 3, h = bh & 7;
        for (int i = 0; i < 8; ++i) {
            const int jj = 2 * (i >> 1) + par, qb = (i & 1) ? 15 - jj : jj;
            attn_unit(lds, QB, KB, VT, O, b * TP + qb * 256, 256, qb * 256, b * TP, 4 * qb + 4, 1 << 30, h, true);
        }
        const int sb = v >> 3, sh = v & 7;
        attn_unit(lds, QB, KB, VT, O, MP + sb * TS, TS, 0, MP + sb * KVSEQ, (KVSEQ + 63) / 64, KVSEQ, sh, false);
    }
}

__device__ __forceinline__ void phase_final(const Params& p) {
    const int tid = threadIdx.x, lane = tid & 63, wave = tid >> 6;
    const int gw = blockIdx.x * 8 + wave, NGW = gridDim.x * 8;
    const float* slots = (const float*)(p.ws + WS_SLOT3); const float* g = p.in[27];
    f32x4 gv[4];
#pragma unroll
    for (int j = 0; j < 4; ++j) gv[j] = *(const f32x4*)(g + 4 * lane + 256 * j);
    for (int row = gw; row < MT; row += 2 * NGW) {
        const int rowb = row + NGW; const bool vb = rowb < MT; const int rb = vb ? rowb : row;
        float* x = p.out + OUT_Y + (size_t)row * 1024; float* y = p.out + OUT_Y + (size_t)rb * 1024;
        f32x4 v[4], u[4];
#pragma unroll
        for (int j = 0; j < 4; ++j) { v[j] = *(const f32x4*)(x + 4 * lane + 256 * j); u[j] = *(const f32x4*)(y + 4 * lane + 256 * j); }
        const float rs = rs_from_slots(slots + (size_t)row * 16, 1.0f / 1024.0f, RMS_EPS), rt = rs_from_slots(slots + (size_t)rb * 16, 1.0f / 1024.0f, RMS_EPS);
#pragma unroll
        for (int j = 0; j < 4; ++j) *(f32x4*)(x + 4 * lane + 256 * j) = v[j] * rs * gv[j];
        if (vb) {
#pragma unroll
            for (int j = 0; j < 4; ++j) *(f32x4*)(y + 4 * lane + 256 * j) = u[j] * rt * gv[j];
        }
    }
}

#define XB_TMO      128
#define XB_XCNT(j)  (256  + 64 * (j))
#define XB_XSUB(j)  (1280 + 64 * (j))
#define XB_XGEN(j)  (2304 + 64 * (j))
#define XB_TOP      3328
#define XB_TOPGEN   3392
#define XCD_BAR_WORDS 3456
#define XB_SPIN_CAP (1u << 18)

__device__ __forceinline__ unsigned xb_ld(unsigned* p)              { return __hip_atomic_load(p, __ATOMIC_RELAXED, __HIP_MEMORY_SCOPE_AGENT); }
__device__ __forceinline__ unsigned xb_add(unsigned* p, unsigned v) { return __hip_atomic_fetch_add(p, v, __ATOMIC_RELAXED, __HIP_MEMORY_SCOPE_AGENT); }
__device__ __forceinline__ unsigned xb_xcc_id() { return (unsigned)__builtin_amdgcn_s_getreg((3 << 11) | 20) & 0xFu; }
#define XB_SPIN(cond, bar) do { unsigned _sp = 0; while (cond) { __builtin_amdgcn_s_sleep(1); \
    if ((++_sp & 255u) == 0u) { if (xb_ld(&(bar)[XB_TMO])) break; if (_sp > XB_SPIN_CAP) { atomicAdd(&(bar)[XB_TMO], 1u); break; } } } } while (0)

struct XcdBarrier {
    unsigned* bar; unsigned x;
    volatile LAS unsigned* st;
};

__device__ __forceinline__ XcdBarrier xcd_barrier_post(unsigned* bar, volatile LAS unsigned* st) {
    XcdBarrier b; b.bar = bar; b.x = xb_xcc_id(); b.st = st;
    if (threadIdx.x == 0) (void)xb_add(&bar[XB_XCNT(b.x)], 1u);
    return b;
}
__device__ __forceinline__ void xcd_barrier_complete(unsigned* bar, unsigned x, unsigned& nloc, unsigned& nx) {
    const unsigned G = gridDim.x * gridDim.y * gridDim.z;
    unsigned sum, cnt, mine, sp = 0u;
    for (;;) {
        sum = 0u; cnt = 0u; mine = 0u;
#pragma unroll
        for (unsigned j = 0; j < 16; ++j) { const unsigned c = xb_ld(&bar[XB_XCNT(j)]); sum += c; cnt += (c > 0u) ? 1u : 0u; mine = (j == x) ? c : mine; }
        if (sum == G) break;
        __builtin_amdgcn_s_sleep(1);
        if ((++sp & 255u) == 0u) { if (xb_ld(&bar[XB_TMO])) break; if (sp > XB_SPIN_CAP) { atomicAdd(&bar[XB_TMO], 1u); break; } }
    }
    nloc = mine > 0u ? mine : 1u; nx = cnt > 0u ? cnt : 1u;
}

__device__ __forceinline__ void xcd_barrier(const XcdBarrier& b) {
    asm volatile("s_waitcnt vmcnt(0)" ::: "memory");
    __syncthreads();
    if (threadIdx.x == 0) {
        unsigned* bar = b.bar;
        __builtin_amdgcn_s_waitcnt(0);
        unsigned nloc = b.st[0], nx = b.st[1];
        if (nloc == 0u) { xcd_barrier_complete(bar, b.x, nloc, nx); b.st[0] = nloc; b.st[1] = nx; }
        const unsigned old = xb_add(&bar[XB_XSUB(b.x)], 1u);
        const unsigned gen = old / nloc;
        if (old + 1u == (gen + 1u) * nloc) {
            __builtin_amdgcn_fence(__ATOMIC_RELEASE, "agent");
            asm volatile("s_waitcnt vmcnt(0)" ::: "memory");
            const unsigned og = xb_add(&bar[XB_TOP], 1u);
            const unsigned tg = og / nx;
            if (og + 1u == (tg + 1u) * nx) xb_add(&bar[XB_TOPGEN], 1u);
            else XB_SPIN(xb_ld(&bar[XB_TOPGEN]) == tg, bar);
            __builtin_amdgcn_fence(__ATOMIC_ACQUIRE, "agent");
            xb_add(&bar[XB_XGEN(b.x)], 1u);
            asm volatile("s_waitcnt vmcnt(0)" ::: "memory");
        } else {
            XB_SPIN(xb_ld(&bar[XB_XGEN(b.x)]) == gen, bar);
            __builtin_amdgcn_fence(__ATOMIC_ACQUIRE, "agent");
            asm volatile("s_waitcnt vmcnt(0)" ::: "memory");
        }
    }
    __syncthreads();
}


__global__ void __launch_bounds__(512, 2) mega_fwd(Params p) {
    extern __shared__ __attribute__((aligned(16))) unsigned char lds_raw[];
    LAS unsigned char* lds = (LAS unsigned char*)lds_raw;
    cg::grid_group grid = cg::this_grid();
    unsigned char* ws = p.ws;
    volatile LAS unsigned* xst = (volatile LAS unsigned*)(lds + 131072);
    if (threadIdx.x < 2) xst[threadIdx.x] = 0u;
    __syncthreads();
    XcdBarrier xbar = xcd_barrier_post((unsigned*)(ws + WS_BAR), xst);
    const int lo = p.ph_lo, hi = p.ph_hi;
#define IN(k) (lo <= (k) && (k) < hi)
#define SEAM(k) do { if (IN(k) && IN((k) + 1)) { if ((k) == 8) { asm volatile("s_waitcnt vmcnt(0)" ::: "memory"); __syncthreads(); grid.sync(); } else xcd_barrier(xbar); } } while (0)
    bf16_t* G = (bf16_t*)(p.out + OUT_Y);
    if (IN(0)) { phase0(p, lds); }
    SEAM(0);
    const int G_ = (int)gridDim.x, bx_ = (int)blockIdx.x;
#define TAIL_SPLIT(units, nx, vb, vg) const int nx = (units) % G_; const int vb = bx_ - nx, vg = G_ - nx
    if (IN(1)) { EpiIn E{(bf16_t*)(ws + WS_ZS), (bf16_t*)(ws + WS_U), G, (float*)(ws + WS_SLOTQ)}; run_gemm(lds, (const bf16_t*)(ws + WS_XN), (const bf16_t*)(ws + WS_WIN), MT, NZ, 1024, E);
        TAIL_SPLIT((MT / 256) * (NZ / 256), nx1, vb1, vg1); if (vb1 >= 0) phase_cache(p, vb1, vg1); }
    SEAM(1);
    if (IN(2)) { phase_mid_tokens(p); phase_mid_conv(p, lds); }
    SEAM(2);
    if (IN(3)) {
        { EpiQ E{(bf16_t*)(ws + WS_QB), (const float*)(ws + WS_ROPE), (const float*)(ws + WS_SLOTQ)}; run_gemm(lds, (const bf16_t*)(ws + WS_ZS), (const bf16_t*)(ws + WS_WUQ), MT, 768, QL, E, 0, ZW); }
        { EpiK E{(bf16_t*)(ws + WS_KB)}; run_gemm(lds, (const bf16_t*)(ws + WS_LATKV), (const bf16_t*)(ws + WS_WUK), MKV, 512, 256, E, 248); }
        { EpiStore E{(bf16_t*)(ws + WS_VT), (size_t)VT_LD}; run_gemm(lds, (const bf16_t*)(ws + WS_WUV), (const bf16_t*)(ws + WS_LATKV), 512, MKV, 256, E, 240); }
    }
    SEAM(3);
    if (IN(4)) { phase_attn(p, lds); }
    SEAM(4);
    if (IN(5)) {
        { EpiGate<false> E{(bf16_t*)(ws + WS_M1), G, 0}; run_gemm(lds, (const bf16_t*)(ws + WS_O), (const bf16_t*)(ws + WS_WAO), MT, 1024, 512, E); }
        { EpiGate<true> E{(bf16_t*)(ws + WS_M1), G, 1024}; run_gemm(lds, (const bf16_t*)(ws + WS_CACT), (const bf16_t*)(ws + WS_WCO), MT, 1024, 512, E); }
    }
    SEAM(5);
    if (IN(6)) { EpiRes E{p.in[0], p.in[1], p.out + OUT_Y, (bf16_t*)(ws + WS_XN), (float*)(ws + WS_SLOT1)}; run_gemm(lds, (const bf16_t*)(ws + WS_M1), (const bf16_t*)(ws + WS_WOUT), MT, 1024, 1024, E);
        TAIL_SPLIT((MT / 256) * 4, nx6, vb6, vg6); if (vb6 >= 0) { phase_pbf(p, vb6, vg6); tr_range(p, lds, W_ITEMS_EARLY, W_ITEMS_UP, vb6, vg6); } }
    SEAM(6);
    if (IN(7)) { { EpiUp E{(bf16_t*)(ws + WS_H), (const float*)(ws + WS_SLOT1)}; run_gemm(lds, (const bf16_t*)(ws + WS_XN), (const bf16_t*)(ws + WS_WUP), MT, 4096, 1024, E); }
        TAIL_SPLIT((MT / 256) * 16, nx7, vb7, vg7); if (vb7 >= 0) tr_range(p, lds, W_ITEMS_UP, W_ITEMS_ALL, vb7, vg7); }
    SEAM(7);
    if (IN(8)) { EpiRes E{p.out + OUT_Y, p.out + OUT_Y + (size_t)MP * 1024, p.out + OUT_Y, (bf16_t*)(ws + WS_XN), (float*)(ws + WS_SLOT2)};
        run_gemm(lds, (const bf16_t*)(ws + WS_H), (const bf16_t*)(ws + WS_WDN), MT, 1024, 4096, E);
        TAIL_SPLIT((MT / 256) * 4, nx8, vb8, vg8);
        if (vb8 >= 0) {
            int kk = 256; asm volatile("" : "+s"(kk));
            pg8::Gemm g{(const bf16_t*)(ws + WS_PBF), (const bf16_t*)(ws + WS_WPP), MT, 1024, kk, 256, 256}; pg8::StaticOrder S; S.init(MT, 1024, vg8, vb8);
            EpiStore E{(bf16_t*)(ws + WS_PP), (size_t)1024};
            pg8::gemm_phase<EpiStore, pg8::StaticOrder, true, true>(lds, g, S, E);
        } }
    SEAM(8);
    if (IN(9)) { EpiPle E{p.out + OUT_Y, (const bf16_t*)(ws + WS_PP), (const float*)(ws + WS_SLOT2), (float*)(ws + WS_SLOT3)}; run_gemm(lds, (const bf16_t*)(ws + WS_XN), (const bf16_t*)(ws + WS_WPG), MT, 1024, 1024, E); }
    SEAM(9);
    if (IN(10)) { phase_final(p); }
#undef IN
#undef SEAM
}

extern "C" void kernel_launch(void* const* d_in, const int* in_sizes, int n_in, void* d_out, int out_size, void* d_ws, size_t ws_size, hipStream_t stream) {
    static int grid_blocks = 0;
    if (grid_blocks == 0) {
        int dev = 0, cus = 0, per_cu = 0;
        (void)hipGetDevice(&dev);
        (void)hipDeviceGetAttribute(&cus, hipDeviceAttributeMultiprocessorCount, dev);
        if (hipFuncSetAttribute((const void*)mega_fwd, hipFuncAttributeMaxDynamicSharedMemorySize, LDS_BYTES) != hipSuccess) fprintf(stderr, "kernel_launch: hipFuncSetAttribute failed\n");
        if (hipOccupancyMaxActiveBlocksPerMultiprocessor(&per_cu, (const void*)mega_fwd, 512, LDS_BYTES) != hipSuccess || per_cu < 1) { fprintf(stderr, "kernel_launch: occupancy query says %d\n", per_cu); per_cu = 1; }
        (void)hipGetLastError();
        grid_blocks = cus * (per_cu > 1 ? 1 : per_cu);
        if (grid_blocks <= 0) grid_blocks = 256;
        if (n_in != 28 || ws_size < ((size_t)1 << 30)) fprintf(stderr, "kernel_launch: unexpected n_in %d / ws_size %zu\n", n_in, ws_size);
    }
    Params p{};
    for (int i = 0; i < 28; ++i) p.in[i] = (const float*)d_in[i];
    p.out = (float*)d_out; p.ws = (unsigned char*)d_ws; p.ph_lo = 0; p.ph_hi = 11;
    (void)hipMemsetAsync((unsigned char*)d_ws + WS_BAR, 0, 16384, stream);
    void* args[] = {&p};
    hipError_t e = hipLaunchCooperativeKernel((const void*)mega_fwd, dim3(grid_blocks), dim3(512), args, LDS_BYTES, stream);
    if (e != hipSuccess) fprintf(stderr, "cooperative launch failed: %s (grid %d)\n", hipGetErrorString(e), grid_blocks);
}
```

```cpp
#include <hip/hip_runtime.h>
#include <hip/hip_cooperative_groups.h>
#include <cstdio>
#include <cstdint>
#include <cmath>
namespace cg = cooperative_groups;
namespace pg8 {
#define PG8_LAS __attribute__((address_space(3)))
typedef unsigned short bf16_t;
typedef short bf16x8 __attribute__((ext_vector_type(8)));
typedef float f32x4 __attribute__((ext_vector_type(4)));
typedef unsigned u32x4 __attribute__((ext_vector_type(4)));
constexpr int BM = 256, BK = 64, HALF = 128, HTB = HALF * BK * 2  , STAGE_BYTES = 8 * HTB, NXCD = 8, WGM = 8;

__host__ __device__ __forceinline__ int lds_byte(int r, int c) { const int st = (r >> 4) * 2 + (c >> 5), rr = r & 15, cc = c & 31, ob = rr * 64 + cc * 2; return st * 1024 + (ob ^ (((ob >> 9) & 1) << 5)); }
__host__ __device__ __forceinline__ void stage_rc(int b, int& R, int& C) { const int st = b / 1024, sb = b % 1024, swz = sb ^ (((sb >> 9) & 1) << 5); R = (st >> 1) * 16 + swz / 64; C = (st & 1) * 32 + (swz % 64) / 2; }
__host__ __device__ __forceinline__ int perm32(int rho) { const int n = rho >> 4, i = rho & 15; return 8 * (i >> 2) + 4 * n + (i & 3); }

struct Unit { int pm, pn; };
struct Gemm { const bf16_t* A; const bf16_t* Bt; int M, N, K, lda, ldb; };

struct StaticOrder {
    int nM, nN, nwg, G, c;
    __host__ __device__ void init(int M, int N, int G_, int c_) { nM = M / BM; nN = N / BM; nwg = nM * nN; G = G_; c = c_; }
    __host__ __device__ bool next(int i, Unit& u) const {
        const long L = (long)i * G + c; if (L >= nwg) return false;
        int wgid = (int)L; { const int q = nwg / NXCD, r = nwg % NXCD, xcd = wgid % NXCD, off = wgid / NXCD; wgid = (xcd < r ? xcd * (q + 1) : r * (q + 1) + (xcd - r) * q) + off; }
        const int nig = WGM * nN, gid = wgid / nig, fm = gid * WGM, gsz = (nM - fm) < WGM ? (nM - fm) : WGM;
        u.pm = fm + ((wgid % nig) % gsz); u.pn = (wgid % nig) / gsz; return true;
    }
    __device__ __forceinline__ void a_ready(const Unit&) const {}
    __device__ __forceinline__ void done(const Unit&) const {}
};

__device__ __forceinline__ unsigned cvt_pk_bf16(float lo, float hi) { unsigned r; asm volatile("v_cvt_pk_bf16_f32 %0, %1, %2" : "=v"(r) : "v"(lo), "v"(hi)); return r; }
template <class Epi, class Sched, bool ALIGN_EPI = false, bool SP2 = false>
__device__ __forceinline__ void gemm_phase(PG8_LAS unsigned char* lds, const Gemm g, const Sched& S, const Epi& E) {
    const int tid = threadIdx.x, wid = __builtin_amdgcn_readfirstlane(tid >> 6), lane = tid & 63, wr = wid >> 2, wc = wid & 3, fr = lane & 15, fq = lane >> 4;
    const int K = g.K, nt = K / BK, LDA = g.lda, LDB = g.ldb;
    unsigned voffA[2], voffB[2];
#pragma unroll
    for (int i = 0; i < 2; ++i) { int R, C; stage_rc(tid * 16 + i * 8192, R, C); const int Rb = Epi::PERM ? ((R & ~31) + perm32(R & 31)) : R;
        voffA[i] = (unsigned)(R * LDA + C) * 2u; voffB[i] = (unsigned)(Rb * LDB + C) * 2u; }
    const size_t kstep = (size_t)(BK * 2);
    const size_t hstepA = (size_t)HALF * LDA * 2, hstepB = (size_t)HALF * LDB * 2;
    const size_t tstepA = 2 * hstepA, tstepB = 2 * hstepB;
    const unsigned ldsw = (unsigned)wid * 1024u;
    const int aoff = lds_byte(wr * 64 + fr, fq * 8), boff = lds_byte(wc * 32 + fr, fq * 8);
#define PG8_SA(b, h) (((b) * 2 + (h)) * HTB)
#define PG8_SB(b, h) ((4 + (b) * 2 + (h)) * HTB)
#define PG8_STAGE(bufoff, gbase, voff) do { _Pragma("unroll") for (int _i = 0; _i < 2; ++_i) \
        __builtin_amdgcn_global_load_lds((const unsigned*)((const char*)(gbase) + (voff)[_i]), (PG8_LAS unsigned*)(lds + (bufoff) + ldsw + _i * 8192), 16, 0, 0); } while (0)
#define PG8_LDA(dst, b, h) do { _Pragma("unroll") for (int m = 0; m < 4; ++m) _Pragma("unroll") for (int k = 0; k < 2; ++k) dst[m][k] = *(const PG8_LAS bf16x8*)(lds + PG8_SA(b, h) + aoff + m * 2048 + k * 1024); } while (0)
#define PG8_LDB(dst, b, h) do { _Pragma("unroll") for (int n = 0; n < 2; ++n) _Pragma("unroll") for (int k = 0; k < 2; ++k) dst[n][k] = *(const PG8_LAS bf16x8*)(lds + PG8_SB(b, h) + boff + n * 2048 + k * 1024); } while (0)
#define PG8_MMA(ai, bj, At, Bt) do { __builtin_amdgcn_s_setprio(1); _Pragma("unroll") for (int m = 0; m < 4; ++m) _Pragma("unroll") for (int n = 0; n < 2; ++n) _Pragma("unroll") for (int k = 0; k < 2; ++k) \
        acc[ai][bj][m][n] = __builtin_amdgcn_mfma_f32_16x16x32_bf16(Bt[n][k], At[m][k], acc[ai][bj][m][n], 0, 0, 0); __builtin_amdgcn_s_setprio(0); } while (0)
#define PG8_WAIT_V(n) asm volatile("s_waitcnt vmcnt(" #n ")" ::: "memory")
#define PG8_WAIT_L(n) asm volatile("s_waitcnt lgkmcnt(" #n ")" ::: "memory")
#define PG8_BAR __builtin_amdgcn_s_barrier()
#define PG8_SCHED __builtin_amdgcn_sched_barrier(0)
    Unit cur, nxt; int ui = 0;
    if (!S.next(0, cur)) return;
    f32x4 acc[2][2][4][2];
#pragma unroll
    for (int a = 0; a < 2; ++a)
#pragma unroll
        for (int b = 0; b < 2; ++b)
#pragma unroll
            for (int m = 0; m < 4; ++m)
#pragma unroll
                for (int n = 0; n < 2; ++n) acc[a][b][m][n] = (f32x4){0.f, 0.f, 0.f, 0.f};
    bf16x8 At[4][2], B0[2][2], B1[2][2];
    const char* cA = (const char*)g.A + (size_t)cur.pm * tstepA; const char* cB = (const char*)g.Bt + (size_t)cur.pn * tstepB;
    S.a_ready(cur);
    if constexpr (SP2) {
        PG8_STAGE(PG8_SB(0, 0), cB, voffB); PG8_STAGE(PG8_SB(0, 1), cB + hstepB, voffB); PG8_STAGE(PG8_SA(0, 0), cA, voffA); PG8_STAGE(PG8_SA(0, 1), cA + hstepA, voffA);
        if (wr == 1) PG8_BAR;
        PG8_WAIT_V(2); PG8_BAR;
        PG8_STAGE(PG8_SB(1, 0), cB + kstep, voffB); PG8_STAGE(PG8_SA(1, 0), cA + kstep, voffA); PG8_STAGE(PG8_SB(1, 1), cB + hstepB + kstep, voffB);
        PG8_WAIT_V(6); PG8_BAR;
    } else {
        PG8_STAGE(PG8_SB(0, 0), cB, voffB); PG8_STAGE(PG8_SA(0, 0), cA, voffA); PG8_STAGE(PG8_SB(0, 1), cB + hstepB, voffB); PG8_STAGE(PG8_SA(0, 1), cA + hstepA, voffA);
        if (wr == 1) PG8_BAR;
        PG8_WAIT_V(4); PG8_BAR;
        PG8_STAGE(PG8_SB(1, 0), cB + kstep, voffB); PG8_STAGE(PG8_SA(1, 0), cA + kstep, voffA); PG8_STAGE(PG8_SB(1, 1), cB + hstepB + kstep, voffB);
        PG8_WAIT_V(6); PG8_BAR;
    }
    for (;;) {
        const bool has_next = S.next(ui + 1, nxt);
        const char* nA = has_next ? (const char*)g.A + (size_t)nxt.pm * tstepA : cA; const char* nB = has_next ? (const char*)g.Bt + (size_t)nxt.pn * tstepB : cB;
#pragma unroll 1
        for (int t = 0; t < nt; t += 2) {
            const bool last = (t == nt - 2);
            const char* a1 = cA + (size_t)(t + 1) * kstep;
            const char* a2 = last ? nA : cA + (size_t)(t + 2) * kstep; const char* b2 = last ? nB : cB + (size_t)(t + 2) * kstep;
            const char* a3 = a2 + kstep; const char* b3 = b2 + kstep;
            if (last && has_next) S.a_ready(nxt);
            if constexpr (SP2) {
            PG8_LDB(B0, 0, 0); PG8_LDB(B1, 0, 1); PG8_SCHED; PG8_LDA(At, 0, 0); PG8_STAGE(PG8_SA(1, 1), a1 + hstepA, voffA);
            PG8_WAIT_V(8); PG8_WAIT_L(0); PG8_BAR; PG8_MMA(0, 0, At, B0); PG8_MMA(0, 1, At, B1); PG8_BAR; PG8_SCHED;
            PG8_LDA(At, 0, 1); PG8_STAGE(PG8_SB(0, 0), b2, voffB); PG8_STAGE(PG8_SB(0, 1), b2 + hstepB, voffB); PG8_STAGE(PG8_SA(0, 0), a2, voffA);
            PG8_WAIT_V(8); PG8_WAIT_L(0); PG8_BAR; PG8_MMA(1, 0, At, B0); PG8_MMA(1, 1, At, B1); PG8_BAR; PG8_SCHED;
            PG8_LDB(B0, 1, 0); PG8_LDB(B1, 1, 1); PG8_SCHED; PG8_LDA(At, 1, 0); PG8_STAGE(PG8_SA(0, 1), a2 + hstepA, voffA);
            PG8_WAIT_V(8); PG8_WAIT_L(0); PG8_BAR; PG8_MMA(0, 0, At, B0); PG8_MMA(0, 1, At, B1); PG8_BAR; PG8_SCHED;
            PG8_LDA(At, 1, 1); PG8_STAGE(PG8_SB(1, 0), b3, voffB); PG8_STAGE(PG8_SB(1, 1), b3 + hstepB, voffB); PG8_STAGE(PG8_SA(1, 0), a3, voffA);
            PG8_WAIT_V(8); PG8_WAIT_L(0); PG8_BAR; PG8_MMA(1, 0, At, B0); PG8_MMA(1, 1, At, B1); PG8_BAR; PG8_SCHED;
            } else {
            PG8_LDB(B0, 0, 0); PG8_SCHED; PG8_LDA(At, 0, 0); PG8_STAGE(PG8_SA(1, 1), a1 + hstepA, voffA);
            PG8_WAIT_L(8); PG8_BAR; PG8_WAIT_L(0); PG8_MMA(0, 0, At, B0); PG8_BAR; PG8_SCHED;
            PG8_LDB(B1, 0, 1); PG8_STAGE(PG8_SB(0, 0), b2, voffB);
            PG8_BAR; PG8_WAIT_L(0); PG8_MMA(0, 1, At, B1); PG8_BAR;
            PG8_LDA(At, 0, 1); PG8_STAGE(PG8_SA(0, 0), a2, voffA);
            PG8_BAR; PG8_WAIT_L(0); PG8_MMA(1, 0, At, B0); PG8_BAR; PG8_SCHED;
            PG8_STAGE(PG8_SB(0, 1), b2 + hstepB, voffB);
            PG8_WAIT_V(6); PG8_BAR; PG8_MMA(1, 1, At, B1); PG8_BAR;
            PG8_LDB(B0, 1, 0); PG8_SCHED; PG8_LDA(At, 1, 0); PG8_STAGE(PG8_SA(0, 1), a2 + hstepA, voffA);
            PG8_WAIT_L(8); PG8_BAR; PG8_WAIT_L(0); PG8_MMA(0, 0, At, B0); PG8_BAR; PG8_SCHED;
            PG8_LDB(B1, 1, 1); PG8_STAGE(PG8_SB(1, 0), b3, voffB);
            PG8_BAR; PG8_WAIT_L(0); PG8_MMA(0, 1, At, B1); PG8_BAR;
            PG8_LDA(At, 1, 1); PG8_STAGE(PG8_SA(1, 0), a3, voffA);
            PG8_BAR; PG8_WAIT_L(0); PG8_MMA(1, 0, At, B0); PG8_BAR; PG8_SCHED;
            PG8_STAGE(PG8_SB(1, 1), b3 + hstepB, voffB);
            PG8_WAIT_V(6); PG8_BAR; PG8_MMA(1, 1, At, B1); PG8_BAR;
            }
        }
        if constexpr (ALIGN_EPI) { if (wr == 0) PG8_BAR; }
        if constexpr (!Epi::AFTER_DRAIN) { E(acc, cur, wr, wc, fr, fq); S.done(cur); }
        if (!has_next) break;
#pragma unroll
        for (int a = 0; a < 2; ++a)
#pragma unroll
            for (int b = 0; b < 2; ++b)
#pragma unroll
                for (int m = 0; m < 4; ++m)
#pragma unroll
                    for (int n = 0; n < 2; ++n) acc[a][b][m][n] = (f32x4){0.f, 0.f, 0.f, 0.f};
        cur = nxt; cA = nA; cB = nB; ++ui;
        if constexpr (ALIGN_EPI) { if (wr == 1) PG8_BAR; }
    }
    PG8_WAIT_V(0);
    if constexpr (!ALIGN_EPI) { if (wr == 0) PG8_BAR; }
    PG8_BAR;
    if constexpr (Epi::AFTER_DRAIN) { E.fused(acc, cur, wr, wc, fr, fq, lds, wid, lane); S.done(cur); }
#undef PG8_SA
#undef PG8_SB
#undef PG8_STAGE
#undef PG8_LDA
#undef PG8_LDB
#undef PG8_MMA
#undef PG8_WAIT_V
#undef PG8_WAIT_L
#undef PG8_BAR
#undef PG8_SCHED
}
}

#define LAS __attribute__((address_space(3)))
typedef unsigned short bf16_t;
typedef short bf16x8 __attribute__((ext_vector_type(8)));
typedef float f32x4 __attribute__((ext_vector_type(4)));
typedef float f32x16 __attribute__((ext_vector_type(16)));
typedef unsigned u32x4 __attribute__((ext_vector_type(4)));
typedef unsigned u32x2 __attribute__((ext_vector_type(2)));
typedef float f32x2_t __attribute__((ext_vector_type(2)));
typedef __bf16 bf16x2_t __attribute__((ext_vector_type(2)));

constexpr int MP = 65536, MS = 512, MT = MP + MS;
constexpr int TP = 4096, TS = 16, PAST = 4096;
constexpr int KVSEQ = PAST + TS;
constexpr int MKV = MP + 32 * KVSEQ;
constexpr int VT_LD = MKV + 64;
constexpr int NZ = 4352, ZW = 1280, QL = 768;
constexpr int IN_W = 4128;
constexpr float RMS_EPS = 1e-6f, LN_EPS = 1e-5f;
constexpr float C2 = 0.10206207261596577f * 1.4426950408889634f;

constexpr size_t OUT_Y = 0, OUT_LATP = (size_t)MT * 1024, OUT_KRP = OUT_LATP + (size_t)MP * 256, OUT_CVP = OUT_KRP + (size_t)MP * 32,
                 OUT_LATS = OUT_CVP + 16 * 30 * 512, OUT_KRS = OUT_LATS + (size_t)MS * 256, OUT_CVS = OUT_KRS + (size_t)MS * 32;

constexpr size_t al256(size_t x) { return (x + 255) & ~(size_t)255; }
constexpr size_t WS_ROPE = 0;
constexpr size_t WS_WIN = al256(WS_ROPE + (size_t)KVSEQ * 16 * 8);
constexpr size_t WS_WUQ = al256(WS_WIN + (size_t)NZ * 1024 * 2);
constexpr size_t WS_WUK = al256(WS_WUQ + (size_t)768 * QL * 2);
constexpr size_t WS_WUV = al256(WS_WUK + (size_t)512 * 256 * 2);
constexpr size_t WS_WAO = al256(WS_WUV + (size_t)512 * 256 * 2);
constexpr size_t WS_WCO = al256(WS_WAO + (size_t)1024 * 512 * 2);
constexpr size_t WS_WOUT = al256(WS_WCO + (size_t)1024 * 512 * 2);
constexpr size_t WS_WUP = al256(WS_WOUT + (size_t)1024 * 1024 * 2);
constexpr size_t WS_WDN = al256(WS_WUP + (size_t)4096 * 1024 * 2);
constexpr size_t WS_WPG = al256(WS_WDN + (size_t)4096 * 1024 * 2);
constexpr size_t WS_WPP = al256(WS_WPG + (size_t)1024 * 1024 * 2);
constexpr size_t WS_SLOT1 = al256(WS_WPP + (size_t)1024 * 256 * 2);
constexpr size_t WS_SLOT2 = al256(WS_SLOT1 + (size_t)MT * 16 * 4);
constexpr size_t WS_SLOT3 = al256(WS_SLOT2 + (size_t)MT * 16 * 4);
constexpr size_t WS_SLOTQ = al256(WS_SLOT3 + (size_t)MT * 16 * 4);
constexpr size_t WS_XN = al256(WS_SLOTQ + (size_t)MT * 16 * 4);
constexpr size_t WS_O = WS_XN;
constexpr size_t WS_CACT = al256(WS_O + (size_t)MT * 512 * 2);
constexpr size_t WS_R = al256(WS_XN + (size_t)MT * 1024 * 2);
constexpr size_t WS_ZS = WS_R, WS_M1 = WS_R, WS_H = WS_R;
constexpr size_t WS_U = al256(WS_ZS + (size_t)MT * ZW * 2);
constexpr size_t WS_VT = WS_U;
constexpr size_t WS_LATKV = al256(WS_VT + (size_t)512 * VT_LD * 2);
constexpr size_t WS_KB = al256(WS_LATKV + (size_t)(MKV + 64) * 256 * 2);
constexpr size_t WS_QB = al256(WS_KB + (size_t)(MKV + 64) * 768 * 2);
constexpr size_t WS_END1 = al256(WS_QB + (size_t)MT * 768 * 2);
constexpr size_t WS_PP = al256(WS_H + (size_t)MT * 4096 * 2);
constexpr size_t WS_PBF = al256(WS_PP + (size_t)MT * 1024 * 2);
constexpr size_t WS_END2 = al256(WS_PBF + (size_t)MT * 256 * 2);
static_assert(WS_END1 <= ((size_t)1 << 30) && WS_END2 <= ((size_t)1 << 30), "workspace map exceeds 1 GiB");
static_assert(WS_CACT + (size_t)MT * 512 * 2 <= WS_R, "O|CACT overlay");
static_assert(WS_U + (size_t)MT * 512 * 2 <= WS_LATKV, "U under V^T");
static_assert(WS_M1 + (size_t)MT * 1024 * 2 <= WS_KB, "M1 overlay");
static_assert(WS_PBF >= WS_M1 + (size_t)MT * 1024 * 2 && WS_PBF >= WS_KB && WS_END2 <= WS_QB, "PBF / PP placement inside the dead K buffer");
constexpr size_t WS_BAR = ((size_t)1 << 30) - 65536;
static_assert(WS_END1 <= WS_BAR && WS_END2 <= WS_BAR, "barrier words");
constexpr int LDS_BYTES = 131072 + 1024;

struct Params { const float* in[28]; float* out; unsigned char* ws; int ph_lo, ph_hi; };

__device__ __forceinline__ unsigned pk2(float lo, float hi) { f32x2_t v = {lo, hi}; bf16x2_t b = __builtin_convertvector(v, bf16x2_t); return __builtin_bit_cast(unsigned, b); }
__device__ __forceinline__ float bflo(unsigned w) { return __uint_as_float(w << 16); }
__device__ __forceinline__ float bfhi(unsigned w) { return __uint_as_float(w & 0xffff0000u); }
__device__ __forceinline__ float sigmoidf_(float x) { return __builtin_amdgcn_rcpf(1.0f + __expf(-x)); }
__device__ __forceinline__ float wave_sum(float v) {
#pragma unroll
    for (int o = 1; o < 64; o <<= 1) v += __shfl_xor(v, o);
    return v;
}
__device__ __forceinline__ u32x4 pack8(const f32x4 a, const f32x4 b) { u32x4 w; w.x = pk2(a[0], a[1]); w.y = pk2(a[2], a[3]); w.z = pk2(b[0], b[1]); w.w = pk2(b[2], b[3]); return w; }
__device__ __forceinline__ void unpack8(const u32x4 w, f32x4& a, f32x4& b) { a = (f32x4){bflo(w.x), bfhi(w.x), bflo(w.y), bfhi(w.y)}; b = (f32x4){bflo(w.z), bfhi(w.z), bflo(w.w), bfhi(w.w)}; }
__device__ __forceinline__ float rs_from_slots(const float* s, float inv_n, float eps) {
    const f32x4 a = *(const f32x4*)s, b = *(const f32x4*)(s + 4), c = *(const f32x4*)(s + 8), d = *(const f32x4*)(s + 12);
    const float t = ((a[0] + a[1]) + (a[2] + a[3])) + ((b[0] + b[1]) + (b[2] + b[3])) + ((c[0] + c[1]) + (c[2] + c[3])) + ((d[0] + d[1]) + (d[2] + d[3]));
    return 1.0f / sqrtf(t * inv_n + eps);
}
__device__ __forceinline__ int pos_of_row(int row) { return row < MP ? (row & (TP - 1)) : PAST + ((row - MP) & (TS - 1)); }
__device__ __forceinline__ int kvrow_of_row(int row) { return row < MP ? row : MP + ((row - MP) >> 4) * KVSEQ + PAST + ((row - MP) & (TS - 1)); }

typedef pg8::Unit Unit;
#define EPI_ARGS const f32x4 (&acc)[2][2][4][2], const Unit& u, int wr, int wc, int fr, int fq
#define FOR_AI_M _Pragma("unroll") for (int ai = 0; ai < 2; ++ai) _Pragma("unroll") for (int m = 0; m < 4; ++m)
#define MEMFENCE asm volatile("" ::: "memory")

struct EpiIn {
    static constexpr bool PERM = true, AFTER_DRAIN = false;
    bf16_t* Zs; bf16_t* U; bf16_t* G; float* slotq;
    __device__ __forceinline__ void operator()(EPI_ARGS) const {
        const int pn = u.pn, cw = wc * 32 + 8 * fq;
        FOR_AI_M {
            const size_t row = (size_t)(u.pm * 256 + ai * 128 + wr * 64 + m * 16 + fr);
            if (pn < 5) {
#pragma unroll
                for (int bj = 0; bj < 2; ++bj) *(u32x4*)(Zs + row * ZW + pn * 256 + bj * 128 + cw) = pack8(acc[ai][bj][m][0], acc[ai][bj][m][1]);
                if (pn < 3) {
                    float ss = 0.f;
#pragma unroll
                    for (int bj = 0; bj < 2; ++bj)
#pragma unroll
                        for (int n = 0; n < 2; ++n) { const f32x4 v = acc[ai][bj][m][n]; ss += (v[0] * v[0] + v[1] * v[1]) + (v[2] * v[2] + v[3] * v[3]); }
                    ss += __shfl_xor(ss, 16); ss += __shfl_xor(ss, 32);
                    if (fq == 0) slotq[row * 16 + pn * 4 + wc] = ss;
                }
            } else if (pn < 9) {
                f32x4 v0, v1;
#pragma unroll
                for (int k = 0; k < 4; ++k) { v0[k] = acc[ai][0][m][0][k] * sigmoidf_(acc[ai][1][m][0][k]); v1[k] = acc[ai][0][m][1][k] * sigmoidf_(acc[ai][1][m][1][k]); }
                *(u32x4*)(U + row * 512 + (pn - 5) * 128 + cw) = pack8(v0, v1);
            } else {
#pragma unroll
                for (int bj = 0; bj < 2; ++bj) { f32x4 v0, v1;
#pragma unroll
                    for (int k = 0; k < 4; ++k) { v0[k] = sigmoidf_(acc[ai][bj][m][0][k]); v1[k] = sigmoidf_(acc[ai][bj][m][1][k]); }
                    *(u32x4*)(G + row * 2048 + (pn - 9) * 256 + bj * 128 + cw) = pack8(v0, v1); }
            }
        }
    }
};
struct EpiQ {
    static constexpr bool PERM = false, AFTER_DRAIN = false;
    bf16_t* QB; const float* rope; const float* slotq;
    __device__ __forceinline__ void operator()(EPI_ARGS) const {
#pragma unroll
        for (int bj = 0; bj < 2; ++bj) {
            const int c0 = u.pn * 256 + bj * 128 + wc * 32;
            const bool isrope = (c0 % 96) == 64;
            FOR_AI_M {
                const int row = u.pm * 256 + ai * 128 + wr * 64 + m * 16 + fr;
                bf16_t* dst = QB + (size_t)row * 768 + c0 + 4 * fq;
                const float* sq = slotq + (size_t)row * 16;
                const f32x4 s0 = *(const f32x4*)sq, s1 = *(const f32x4*)(sq + 4), s2 = *(const f32x4*)(sq + 8);
                const float rq = 1.0f / sqrtf((((s0[0] + s0[1]) + (s0[2] + s0[3])) + ((s1[0] + s1[1]) + (s1[2] + s1[3])) + ((s2[0] + s2[1]) + (s2[2] + s2[3]))) * (1.0f / (float)QL) + RMS_EPS);
                f32x4 a = acc[ai][bj][m][0] * rq, b = acc[ai][bj][m][1] * rq;
                if (isrope) {
                    const float* cs = rope + ((size_t)pos_of_row(row) * 16 + 4 * fq) * 2;
                    const f32x4 t0 = *(const f32x4*)cs, t1 = *(const f32x4*)(cs + 4);
                    const f32x4 c = {t0[0], t0[2], t1[0], t1[2]}, s = {t0[1], t0[3], t1[1], t1[3]};
                    const f32x4 o1 = a * c - b * s, o2 = b * c + a * s; a = o1; b = o2;
                }
                a = a * C2; b = b * C2;
                u32x2 w0, w1; w0.x = pk2(a[0], a[1]); w0.y = pk2(a[2], a[3]); w1.x = pk2(b[0], b[1]); w1.y = pk2(b[2], b[3]);
                *(u32x2*)dst = w0; *(u32x2*)(dst + 16) = w1;
                MEMFENCE;
            }
        }
    }
};
struct EpiK {
    static constexpr bool PERM = true, AFTER_DRAIN = false;
    bf16_t* KB;
    __device__ __forceinline__ void operator()(EPI_ARGS) const {
        FOR_AI_M {
            const size_t row = (size_t)(u.pm * 256 + ai * 128 + wr * 64 + m * 16 + fr);
#pragma unroll
            for (int bj = 0; bj < 2; ++bj) { const int c = u.pn * 256 + bj * 128 + wc * 32 + 8 * fq; *(u32x4*)(KB + row * 768 + (c >> 6) * 96 + (c & 63)) = pack8(acc[ai][bj][m][0], acc[ai][bj][m][1]); }
        }
    }
};
struct EpiStore {
    static constexpr bool PERM = true, AFTER_DRAIN = false;
    bf16_t* O; size_t ldc;
    __device__ __forceinline__ void operator()(EPI_ARGS) const {
        FOR_AI_M {
            const size_t row = (size_t)(u.pm * 256 + ai * 128 + wr * 64 + m * 16 + fr);
#pragma unroll
            for (int bj = 0; bj < 2; ++bj) { const int c = u.pn * 256 + bj * 128 + wc * 32 + 8 * fq; *(u32x4*)(O + row * ldc + c) = pack8(acc[ai][bj][m][0], acc[ai][bj][m][1]); }
        }
    }
};
template <bool ACCUM> struct EpiGate {
    static constexpr bool PERM = true, AFTER_DRAIN = false;
    bf16_t* M1; const bf16_t* G; int goff;
    __device__ __forceinline__ void operator()(EPI_ARGS) const {
        FOR_AI_M {
            const size_t row = (size_t)(u.pm * 256 + ai * 128 + wr * 64 + m * 16 + fr);
#pragma unroll
            for (int bj = 0; bj < 2; ++bj) { const int c = u.pn * 256 + bj * 128 + wc * 32 + 8 * fq;
                f32x4 g0, g1; unpack8(*(const u32x4*)(G + row * 2048 + goff + c), g0, g1);
                f32x4 v0 = acc[ai][bj][m][0] * g0, v1 = acc[ai][bj][m][1] * g1;
                if (ACCUM) { f32x4 o0, o1; unpack8(*(const u32x4*)(M1 + row * 1024 + c), o0, o1); v0 = v0 + o0; v1 = v1 + o1; }
                *(u32x4*)(M1 + row * 1024 + c) = pack8(v0, v1); }
            if (m & 1) MEMFENCE;
        }
    }
};
struct EpiRes {
    static constexpr bool PERM = true, AFTER_DRAIN = false;
    const float* base_p; const float* base_s; float* X; bf16_t* XB; float* slots;
    __device__ __forceinline__ void operator()(EPI_ARGS) const {
        FOR_AI_M {
            const int row = u.pm * 256 + ai * 128 + wr * 64 + m * 16 + fr;
            const float* bs = row < MP ? base_p + (size_t)row * 1024 : base_s + (size_t)(row - MP) * 1024;
            float ss = 0.f;
#pragma unroll
            for (int bj = 0; bj < 2; ++bj) { const int c = u.pn * 256 + bj * 128 + wc * 32 + 8 * fq;
                const f32x4 v0 = acc[ai][bj][m][0] + *(const f32x4*)(bs + c), v1 = acc[ai][bj][m][1] + *(const f32x4*)(bs + c + 4);
                *(f32x4*)(X + (size_t)row * 1024 + c) = v0; *(f32x4*)(X + (size_t)row * 1024 + c + 4) = v1;
                *(u32x4*)(XB + (size_t)row * 1024 + c) = pack8(v0, v1);
                ss += (v0[0] * v0[0] + v0[1] * v0[1]) + (v0[2] * v0[2] + v0[3] * v0[3]) + (v1[0] * v1[0] + v1[1] * v1[1]) + (v1[2] * v1[2] + v1[3] * v1[3]); }
            ss += __shfl_xor(ss, 16); ss += __shfl_xor(ss, 32);
            if (fq == 0) slots[(size_t)row * 16 + u.pn * 4 + wc] = ss;
            if (m & 1) MEMFENCE;
        }
    }
};
struct EpiUp {
    static constexpr bool PERM = true, AFTER_DRAIN = false;
    bf16_t* H; const float* slots;
    __device__ __forceinline__ void operator()(EPI_ARGS) const {
        FOR_AI_M {
            const size_t row = (size_t)(u.pm * 256 + ai * 128 + wr * 64 + m * 16 + fr);
            const float rs = rs_from_slots(slots + row * 16, 1.0f / 1024.0f, RMS_EPS);
#pragma unroll
            for (int bj = 0; bj < 2; ++bj) { const int c = u.pn * 256 + bj * 128 + wc * 32 + 8 * fq;
                f32x4 v0 = acc[ai][bj][m][0] * rs, v1 = acc[ai][bj][m][1] * rs;
#pragma unroll
                for (int k = 0; k < 4; ++k) { const float a = fmaxf(v0[k], 0.f), b = fmaxf(v1[k], 0.f); v0[k] = a * a; v1[k] = b * b; }
                *(u32x4*)(H + row * 4096 + c) = pack8(v0, v1); }
            if (m & 1) MEMFENCE;
        }
    }
};
struct EpiPle {
    static constexpr bool PERM = true, AFTER_DRAIN = false;
    float* X; const bf16_t* PP; const float* slots2; float* slots3;
    __device__ __forceinline__ void operator()(EPI_ARGS) const {
        FOR_AI_M {
            const size_t row = (size_t)(u.pm * 256 + ai * 128 + wr * 64 + m * 16 + fr);
            const float rs = rs_from_slots(slots2 + row * 16, 1.0f / 1024.0f, RMS_EPS);
            float ss = 0.f;
#pragma unroll
            for (int bj = 0; bj < 2; ++bj) { const int c = u.pn * 256 + bj * 128 + wc * 32 + 8 * fq;
                f32x4 p0, p1; unpack8(*(const u32x4*)(PP + row * 1024 + c), p0, p1);
                f32x4 v0 = *(const f32x4*)(X + row * 1024 + c), v1 = *(const f32x4*)(X + row * 1024 + c + 4);
#pragma unroll
                for (int k = 0; k < 4; ++k) { v0[k] += sigmoidf_(acc[ai][bj][m][0][k] * rs) * p0[k]; v1[k] += sigmoidf_(acc[ai][bj][m][1][k] * rs) * p1[k]; }
                *(f32x4*)(X + row * 1024 + c) = v0; *(f32x4*)(X + row * 1024 + c + 4) = v1;
                ss += (v0[0] * v0[0] + v0[1] * v0[1]) + (v0[2] * v0[2] + v0[3] * v0[3]) + (v1[0] * v1[0] + v1[1] * v1[1]) + (v1[2] * v1[2] + v1[3] * v1[3]); }
            ss += __shfl_xor(ss, 16); ss += __shfl_xor(ss, 32);
            if (fq == 0) slots3[row * 16 + u.pn * 4 + wc] = ss;
            MEMFENCE;
        }
    }
};

struct EpiAtomic {
    static constexpr bool PERM = true, AFTER_DRAIN = false;
    float* X;
    __device__ __forceinline__ void operator()(EPI_ARGS) const {
        FOR_AI_M {
            const size_t row = (size_t)(u.pm * 256 + ai * 128 + wr * 64 + m * 16 + fr);
#pragma unroll
            for (int bj = 0; bj < 2; ++bj) { const int c = u.pn * 256 + bj * 128 + wc * 32 + 8 * fq; float* d = X + row * 1024 + c;
#pragma unroll
                for (int k = 0; k < 4; ++k) { (void)__hip_atomic_fetch_add(d + k, acc[ai][bj][m][0][k], __ATOMIC_RELAXED, __HIP_MEMORY_SCOPE_AGENT); (void)__hip_atomic_fetch_add(d + 4 + k, acc[ai][bj][m][1][k], __ATOMIC_RELAXED, __HIP_MEMORY_SCOPE_AGENT); } }
        }
    }
};
struct OneUnit {
    int pm, pn;
    __device__ __forceinline__ bool next(int i, Unit& u) const { if (i != 0) return false; u.pm = pm; u.pn = pn; return true; }
    __device__ __forceinline__ void a_ready(const Unit&) const {}
    __device__ __forceinline__ void done(const Unit&) const {}
};
__device__ __forceinline__ void phase_sample_post(const Params& p) {
    const int lane = threadIdx.x & 63, gw = blockIdx.x * 8 + (threadIdx.x >> 6), NGW = gridDim.x * 8;
    bf16_t* XB = (bf16_t*)(p.ws + WS_XN); float* slots = (float*)(p.ws + WS_SLOT2);
    for (int r = gw; r < MS; r += NGW) {
        const size_t row = (size_t)MP + r; const float* x = p.out + OUT_Y + row * 1024; float s = 0.f;
#pragma unroll
        for (int j = 0; j < 4; ++j) { const f32x4 v = *(const f32x4*)(x + 4 * lane + 256 * j); s += (v[0] * v[0] + v[1] * v[1]) + (v[2] * v[2] + v[3] * v[3]);
            u32x2 w; w.x = pk2(v[0], v[1]); w.y = pk2(v[2], v[3]); *(u32x2*)(XB + row * 1024 + 4 * lane + 256 * j) = w; }
        s = wave_sum(s);
        if (lane < 16) slots[row * 16 + lane] = lane == 0 ? s : 0.f;
    }
}
template <class Epi> __device__ __forceinline__ void run_gemm(LAS unsigned char* lds, const bf16_t* A, const bf16_t* Bt, int M, int N, int K, const Epi& E, int rot = 0, int lda = 0) {
    asm volatile("" : "+s"(K));
    pg8::Gemm g{A, Bt, M, N, K, lda ? lda : K, K}; pg8::StaticOrder S; S.init(M, N, (int)gridDim.x, (int)((blockIdx.x + rot) % gridDim.x));
    pg8::gemm_phase<Epi, pg8::StaticOrder, true, true>(lds, g, S, E);
}

__device__ __forceinline__ void tr_item(const float* W, int ldw, int K, bf16_t* WT, int src_c0, int dst_r0, int k0, const float* ksc, LAS float* scr, int lane) {
    float tv[32];
#pragma unroll
    for (int i = 0; i < 32; ++i) { const int kk = 2 * i + (lane >> 5); tv[i] = 0.f;
        if (src_c0 >= 0) { tv[i] = W[(size_t)(k0 + kk) * ldw + src_c0 + (lane & 31)]; if (ksc) tv[i] *= ksc[k0 + kk]; } }
#pragma unroll
    for (int i = 0; i < 32; ++i) { const int kk = 2 * i + (lane >> 5); scr[kk * 33 + (lane & 31)] = tv[i]; }
    asm volatile("s_waitcnt lgkmcnt(0)" ::: "memory");
    const int c = lane & 7;
#pragma unroll
    for (int j = 0; j < 4; ++j) { const int n = (lane >> 3) + 8 * j; const LAS float* s = scr + (8 * c) * 33 + n;
        u32x4 o; o.x = pk2(s[0 * 33], s[1 * 33]); o.y = pk2(s[2 * 33], s[3 * 33]); o.z = pk2(s[4 * 33], s[5 * 33]); o.w = pk2(s[6 * 33], s[7 * 33]);
        *(u32x4*)(WT + (size_t)(dst_r0 + n) * K + k0 + 8 * c) = o; }
    asm volatile("s_waitcnt lgkmcnt(0)" ::: "memory");
}
__device__ __forceinline__ int win_src_col(int n) {
    if (n < 1056) return n;
    if (n < 1280) return -1;
    if (n < 2304) { const int q = n - 1280, i = q >> 8, j = q & 255; return j < 128 ? 1056 + 128 * i + j : 1056 + 512 + 128 * i + (j - 128); }
    return 2080 + (n - 2304);
}
__device__ __forceinline__ bool tr_mat(int& r, const float* W, int K, int N, bf16_t* WT, const float* ksc, LAS float* scr, int lane) {
    const int nblk = N / 32, items = (K / 64) * nblk;
    if (r >= items) { r -= items; return false; }
    const int kb = r / nblk, nb = r % nblk;
    tr_item(W, N, K, WT, 32 * nb, 32 * nb, 64 * kb, ksc, scr, lane);
    return true;
}
constexpr int W_I_WIN = 16 * (NZ / 32);
constexpr int W_ITEMS_EARLY = W_I_WIN + 12 * 24 + 4 * 16 * 2 + 8 * 32 * 2 + 16 * 32;
constexpr int W_ITEMS_UP = W_ITEMS_EARLY + 16 * 128;
constexpr int W_ITEMS_ALL = W_ITEMS_UP + 64 * 32 + 16 * 32 + 4 * 32;
__device__ __forceinline__ void tr_range(const Params& p, LAS unsigned char* lds, int lo, int hi, int vb, int vg) {
    const int tid = threadIdx.x, lane = tid & 63, wave = tid >> 6;
    const int gw = vb * 8 + wave, NGW = vg * 8;
    unsigned char* ws = p.ws;
    LAS float* scr = (LAS float*)(lds + wave * 16384);
    constexpr int I_WIN = W_I_WIN;
    for (int it = lo + gw; it < hi; it += NGW) {
        int r = it;
        if (r < I_WIN) { const int nblk = NZ / 32, kb = r / nblk, nb = r % nblk; tr_item(p.in[8], IN_W, 1024, (bf16_t*)(ws + WS_WIN), win_src_col(32 * nb), 32 * nb, 64 * kb, nullptr, scr, lane); continue; }
        r -= I_WIN;
        if (tr_mat(r, p.in[10], QL, 768, (bf16_t*)(ws + WS_WUQ), p.in[9], scr, lane)) continue;
        if (tr_mat(r, p.in[12], 256, 512, (bf16_t*)(ws + WS_WUK), nullptr, scr, lane)) continue;
        if (tr_mat(r, p.in[13], 256, 512, (bf16_t*)(ws + WS_WUV), nullptr, scr, lane)) continue;
        if (tr_mat(r, p.in[14], 512, 1024, (bf16_t*)(ws + WS_WAO), nullptr, scr, lane)) continue;
        if (tr_mat(r, p.in[19], 512, 1024, (bf16_t*)(ws + WS_WCO), nullptr, scr, lane)) continue;
        if (tr_mat(r, p.in[20], 1024, 1024, (bf16_t*)(ws + WS_WOUT), nullptr, scr, lane)) continue;
        if (tr_mat(r, p.in[22], 1024, 4096, (bf16_t*)(ws + WS_WUP), p.in[21], scr, lane)) continue;
        if (tr_mat(r, p.in[23], 4096, 1024, (bf16_t*)(ws + WS_WDN), nullptr, scr, lane)) continue;
        if (tr_mat(r, p.in[25], 1024, 1024, (bf16_t*)(ws + WS_WPG), p.in[24], scr, lane)) continue;
        tr_mat(r, p.in[26], 256, 1024, (bf16_t*)(ws + WS_WPP), nullptr, scr, lane);
    }
}
__device__ __forceinline__ void phase0(const Params& p, LAS unsigned char* lds) {
    const int tid = threadIdx.x, lane = tid & 63, wave = tid >> 6;
    const int gw = blockIdx.x * 8 + wave, NGW = gridDim.x * 8;
    const size_t gt = (size_t)blockIdx.x * 512 + tid, NGT = (size_t)gridDim.x * 512;
    unsigned char* ws = p.ws;
    LAS float* scr = (LAS float*)(lds + wave * 16384);
    tr_range(p, lds, 0, W_ITEMS_EARLY, (int)blockIdx.x, (int)gridDim.x);
    {
        const float* g = p.in[7]; bf16_t* XN = (bf16_t*)(ws + WS_XN);
        f32x4 gv[4];
#pragma unroll
        for (int j = 0; j < 4; ++j) gv[j] = *(const f32x4*)(g + 4 * lane + 256 * j);
        for (int row = gw; row < MT; row += 2 * NGW) {
            const int rowb = row + NGW; const bool vb = rowb < MT; const int rb = vb ? rowb : row;
            const float* xr = row < MP ? p.in[0] + (size_t)row * 1024 : p.in[1] + (size_t)(row - MP) * 1024;
            const float* xq = rb < MP ? p.in[0] + (size_t)rb * 1024 : p.in[1] + (size_t)(rb - MP) * 1024;
            f32x4 v[4], u[4]; float s = 0.f, t = 0.f;
#pragma unroll
            for (int j = 0; j < 4; ++j) { v[j] = *(const f32x4*)(xr + 4 * lane + 256 * j); u[j] = *(const f32x4*)(xq + 4 * lane + 256 * j); }
#pragma unroll
            for (int j = 0; j < 4; ++j) { s += (v[j][0] * v[j][0] + v[j][1] * v[j][1]) + (v[j][2] * v[j][2] + v[j][3] * v[j][3]); t += (u[j][0] * u[j][0] + u[j][1] * u[j][1]) + (u[j][2] * u[j][2] + u[j][3] * u[j][3]); }
            const float rs = 1.0f / sqrtf(wave_sum(s) * (1.0f / 1024.0f) + RMS_EPS), rt = 1.0f / sqrtf(wave_sum(t) * (1.0f / 1024.0f) + RMS_EPS);
#pragma unroll
            for (int j = 0; j < 4; ++j) { const f32x4 o = v[j] * rs * gv[j]; u32x2 w; w.x = pk2(o[0], o[1]); w.y = pk2(o[2], o[3]); *(u32x2*)(XN + (size_t)row * 1024 + 4 * lane + 256 * j) = w; }
            if (vb) {
#pragma unroll
                for (int j = 0; j < 4; ++j) { const f32x4 o = u[j] * rt * gv[j]; u32x2 w; w.x = pk2(o[0], o[1]); w.y = pk2(o[2], o[3]); *(u32x2*)(XN + (size_t)rowb * 1024 + 4 * lane + 256 * j) = w; }
            }
        }
    }
    {
        float* R = (float*)(ws + WS_ROPE);
        for (size_t e = gt; e < (size_t)KVSEQ * 16; e += NGT) {
            const int pos = (int)(e >> 4), i = (int)(e & 15);
            const float inv = exp2f(-(float)i * (13.287712379549449f / 16.0f));
            const float ang = (float)pos * inv;
            R[2 * e] = cosf(ang); R[2 * e + 1] = sinf(ang);
        }
    }
}

__device__ __forceinline__ void phase_cache(const Params& p, int vb, int vg, int parts) {
    const size_t gt = (size_t)vb * 512 + threadIdx.x, NGT = (size_t)vg * 512;
    unsigned char* ws = p.ws;
    if (parts & 1) {
        const float* src = p.in[4]; bf16_t* L = (bf16_t*)(ws + WS_LATKV);
        for (size_t e0 = gt; e0 < (size_t)32 * PAST * 32; e0 += 4 * NGT) {
            f32x4 a[4], bb[4];
#pragma unroll
            for (int i = 0; i < 4; ++i) { const size_t e = e0 + i * NGT; if (e < (size_t)32 * PAST * 32) { a[i] = *(const f32x4*)(src + e * 8); bb[i] = *(const f32x4*)(src + e * 8 + 4); } }
#pragma unroll
            for (int i = 0; i < 4; ++i) { const size_t e = e0 + i * NGT; if (e < (size_t)32 * PAST * 32) {
                const size_t row = e >> 5; const int c8 = (int)(e & 31); const int b = (int)(row >> 12), k = (int)(row & 4095);
                *(u32x4*)(L + (size_t)(MP + b * KVSEQ + k) * 256 + c8 * 8) = pack8(a[i], bb[i]); } }
        }
    }
    if (parts & 2) {
        const float* src = p.in[5]; bf16_t* KB = (bf16_t*)(ws + WS_KB);
        for (size_t e = gt; e < (size_t)32 * PAST * 4; e += NGT) {
            const size_t row = e >> 2; const int c8 = (int)(e & 3); const int b = (int)(row >> 12), k = (int)(row & 4095);
            const f32x4 a = *(const f32x4*)(src + row * 32 + c8 * 8), bb = *(const f32x4*)(src + row * 32 + c8 * 8 + 4);
            const u32x4 w = pack8(a, bb); bf16_t* d = KB + (size_t)(MP + b * KVSEQ + k) * 768 + 64 + c8 * 8;
#pragma unroll
            for (int h = 0; h < 8; ++h) *(u32x4*)(d + h * 96) = w;
        }
    }
}
__device__ __forceinline__ void phase_pbf(const Params& p, int vb, int vg) {
    const size_t gt = (size_t)vb * 512 + threadIdx.x, NGT = (size_t)vg * 512;
    bf16_t* P = (bf16_t*)(p.ws + WS_PBF);
    for (size_t e = gt; e < (size_t)MT * 32; e += NGT) {
        const float* s = e < (size_t)MP * 32 ? p.in[2] + e * 8 : p.in[3] + (e - (size_t)MP * 32) * 8;
        *(u32x4*)(P + e * 8) = pack8(*(const f32x4*)s, *(const f32x4*)(s + 4));
    }
}
struct TokIn { u32x4 kv, kr; f32x4 t0, t1, t2, t3; };
__device__ __forceinline__ TokIn tok_load(const bf16_t* Zs, const float* rope, int row, int lane) {
    TokIn r; const bf16_t* z = Zs + (size_t)row * ZW;
    r.kv = (u32x4){0u, 0u, 0u, 0u}; r.kr = r.kv; r.t0 = (f32x4){0.f, 0.f, 0.f, 0.f}; r.t1 = r.t0; r.t2 = r.t0; r.t3 = r.t0;
    if (lane < 32) r.kv = *(const u32x4*)(z + 768 + 8 * lane);
    if (lane < 4) { r.kr = *(const u32x4*)(z + 1024 + 8 * lane);
        const float* cs = rope + ((size_t)pos_of_row(row) * 16 + 8 * (lane & 1)) * 2;
        r.t0 = *(const f32x4*)cs; r.t1 = *(const f32x4*)(cs + 4); r.t2 = *(const f32x4*)(cs + 8); r.t3 = *(const f32x4*)(cs + 12); }
    return r;
}
__device__ __forceinline__ void tok_proc(const Params& p, const TokIn& in, int row, int lane, bf16_t* L, bf16_t* KB, const f32x4& kg0, const f32x4& kg1) {
    const int kvrow = kvrow_of_row(row);
    f32x4 b0, b1; unpack8(in.kv, b0, b1);
    const float s = (b0[0] * b0[0] + b0[1] * b0[1]) + (b0[2] * b0[2] + b0[3] * b0[3]) + (b1[0] * b1[0] + b1[1] * b1[1]) + (b1[2] * b1[2] + b1[3] * b1[3]);
    const float rk = 1.0f / sqrtf(wave_sum(s) * (1.0f / 256.0f) + RMS_EPS);
    if (lane < 32) {
        const f32x4 l0 = b0 * rk * kg0, l1 = b1 * rk * kg1;
        float* o = row < MP ? p.out + OUT_LATP + (size_t)row * 256 : p.out + OUT_LATS + (size_t)(row - MP) * 256;
        *(f32x4*)(o + 8 * lane) = l0; *(f32x4*)(o + 8 * lane + 4) = l1;
        *(u32x4*)(L + (size_t)kvrow * 256 + 8 * lane) = pack8(l0, l1);
    }
    f32x4 c0, c1; unpack8(in.kr, c0, c1);
    f32x4 d0, d1;
#pragma unroll
    for (int k = 0; k < 4; ++k) { d0[k] = __shfl_xor(c0[k], 2); d1[k] = __shfl_xor(c1[k], 2); }
    if (lane < 4) {
        const f32x4 cc0 = {in.t0[0], in.t0[2], in.t1[0], in.t1[2]}, ss0 = {in.t0[1], in.t0[3], in.t1[1], in.t1[3]}, cc1 = {in.t2[0], in.t2[2], in.t3[0], in.t3[2]}, ss1 = {in.t2[1], in.t2[3], in.t3[1], in.t3[3]};
        f32x4 o0, o1;
        if (lane < 2) { o0 = c0 * cc0 - d0 * ss0; o1 = c1 * cc1 - d1 * ss1; }
        else { o0 = c0 * cc0 + d0 * ss0; o1 = c1 * cc1 + d1 * ss1; }
        float* o = row < MP ? p.out + OUT_KRP + (size_t)row * 32 : p.out + OUT_KRS + (size_t)(row - MP) * 32;
        *(f32x4*)(o + 8 * lane) = o0; *(f32x4*)(o + 8 * lane + 4) = o1;
        const u32x4 w = pack8(o0, o1); bf16_t* d = KB + (size_t)kvrow * 768 + 64 + 8 * lane;
#pragma unroll
        for (int h = 0; h < 8; ++h) *(u32x4*)(d + h * 96) = w;
    }
}
__device__ __forceinline__ void phase_mid_tokens(const Params& p) {
    const int tid = threadIdx.x, lane = tid & 63, wave = tid >> 6;
    const int gw = blockIdx.x * 8 + wave, NGW = gridDim.x * 8;
    unsigned char* ws = p.ws;
    const bf16_t* Zs = (const bf16_t*)(ws + WS_ZS); bf16_t* L = (bf16_t*)(ws + WS_LATKV); bf16_t* KB = (bf16_t*)(ws + WS_KB);
    const float* rope = (const float*)(ws + WS_ROPE);
    const float* kg = p.in[11];
    f32x4 kg0 = {1.f, 1.f, 1.f, 1.f}, kg1 = kg0;
    if (lane < 32) { kg0 = *(const f32x4*)(kg + 8 * lane); kg1 = *(const f32x4*)(kg + 8 * lane + 4); }
    for (int row = gw; row < MT; row += 4 * NGW) {
        const int r1 = row + NGW, r2 = row + 2 * NGW, r3 = row + 3 * NGW; const bool v1 = r1 < MT, v2 = r2 < MT, v3 = r3 < MT;
        const TokIn A = tok_load(Zs, rope, row, lane), B = tok_load(Zs, rope, v1 ? r1 : row, lane), C = tok_load(Zs, rope, v2 ? r2 : row, lane), D = tok_load(Zs, rope, v3 ? r3 : row, lane);
        tok_proc(p, A, row, lane, L, KB, kg0, kg1);
        if (v1) tok_proc(p, B, r1, lane, L, KB, kg0, kg1);
        if (v2) tok_proc(p, C, r2, lane, L, KB, kg0, kg1);
        if (v3) tok_proc(p, D, r3, lane, L, KB, kg0, kg1);
    }
}
__device__ __forceinline__ void phase_mid_conv(const Params& p, LAS unsigned char* lds) {
    const int tid = threadIdx.x, lane = tid & 63, wave = tid >> 6;
    unsigned char* ws = p.ws;
    const bf16_t* U = (const bf16_t*)(ws + WS_U); bf16_t* CACT = (bf16_t*)(ws + WS_CACT);
    LAS unsigned* ut = (LAS unsigned*)lds;
    LAS float* dwb = (LAS float*)(lds + 62 * 1024);
    const int cp = tid & 255, half = tid >> 8;
    f32x2_t w[31];
#pragma unroll
    for (int j = 0; j < 31; ++j) w[j] = *(const f32x2_t*)(p.in[15] + j * 512 + 2 * cp);
    const f32x2_t cb = *(const f32x2_t*)(p.in[16] + 2 * cp);
    const f32x4 lg0 = *(const f32x4*)(p.in[17] + 8 * lane), lg1 = *(const f32x4*)(p.in[17] + 8 * lane + 4), lb0 = *(const f32x4*)(p.in[18] + 8 * lane), lb1 = *(const f32x4*)(p.in[18] + 8 * lane + 4);
    constexpr int NBLK = MP / 32 + 32;
    u32x4 stg[8];
#define CONV_LOAD(cbk_) do { const int cbk__ = (cbk_); const bool pr_ = cbk__ < MP / 32; const int sb_ = cbk__ - MP / 32; \
        const int t0_ = pr_ ? (cbk__ & 127) * 32 : 0, R_ = pr_ ? 32 : 16, row0_ = pr_ ? cbk__ * 32 : MP + sb_ * 16; \
        _Pragma("unroll") for (int i_ = 0; i_ < 8; ++i_) { const int ch_ = tid + 512 * i_, rr_ = ch_ >> 6, c8_ = ch_ & 63, t_ = t0_ - 30 + rr_; \
            u32x4 w_ = {0u, 0u, 0u, 0u}; \
            if (rr_ < 30 + R_) { if (t_ >= 0) w_ = *(const u32x4*)(U + (size_t)(row0_ + rr_ - 30) * 512 + c8_ * 8); \
                else if (!pr_) { const float* hs_ = p.in[6] + ((size_t)sb_ * 30 + rr_) * 512 + c8_ * 8; w_ = pack8(*(const f32x4*)hs_, *(const f32x4*)(hs_ + 4)); } } \
            stg[i_] = w_; } } while (0)
    if ((int)blockIdx.x < NBLK) CONV_LOAD(blockIdx.x);
    for (int cbk = blockIdx.x; cbk < NBLK; cbk += gridDim.x) {
        const bool prompt = cbk < MP / 32;
        const int sb = cbk - MP / 32;
        const int R = prompt ? 32 : 16;
        const int row0 = prompt ? cbk * 32 : MP + sb * 16;
#pragma unroll
        for (int i = 0; i < 8; ++i) { const int ch = tid + 512 * i, rr = ch >> 6, c8 = ch & 63; if (rr < 62) *(LAS u32x4*)(ut + rr * 256 + c8 * 4) = stg[i]; }
        __syncthreads();
        if (cbk + (int)gridDim.x < NBLK) CONV_LOAD(cbk + gridDim.x);
        if (half * 16 < R) {
#pragma unroll 1
            for (int hh = 0; hh < 2; ++hh) {
                const int tb = half * 16 + hh * 8;
                f32x2_t uu[38];
#pragma unroll
                for (int r = 0; r < 38; ++r) { const unsigned x = ut[(tb + r) * 256 + cp]; uu[r] = (f32x2_t){bflo(x), bfhi(x)}; }
#pragma unroll
                for (int tt = 0; tt < 8; ++tt) {
                    f32x2_t a = cb;
#pragma unroll
                    for (int j = 0; j < 31; ++j) a = __builtin_elementwise_fma(w[j], uu[tt + j], a);
                    *(LAS f32x2_t*)(dwb + (tb + tt) * 512 + 2 * cp) = a;
                }
            }
        }
        __syncthreads();
#pragma unroll
        for (int i = 0; i < 4; ++i) {
            const int tl = wave * 4 + i;
            if (tl < R) {
                const f32x4 v0 = *(const LAS f32x4*)(dwb + tl * 512 + 8 * lane), v1 = *(const LAS f32x4*)(dwb + tl * 512 + 8 * lane + 4);
                const float mean = wave_sum((v0[0] + v0[1]) + (v0[2] + v0[3]) + (v1[0] + v1[1]) + (v1[2] + v1[3])) * (1.0f / 512.0f);
                const f32x4 e0 = v0 - mean, e1 = v1 - mean;
                const float var = wave_sum((e0[0] * e0[0] + e0[1] * e0[1]) + (e0[2] * e0[2] + e0[3] * e0[3]) + (e1[0] * e1[0] + e1[1] * e1[1]) + (e1[2] * e1[2] + e1[3] * e1[3])) * (1.0f / 512.0f);
                const float rstd = 1.0f / sqrtf(var + LN_EPS);
                f32x4 y0 = e0 * rstd * lg0 + lb0, y1 = e1 * rstd * lg1 + lb1;
#pragma unroll
                for (int k = 0; k < 4; ++k) { y0[k] = y0[k] * sigmoidf_(y0[k]); y1[k] = y1[k] * sigmoidf_(y1[k]); }
                *(u32x4*)(CACT + (size_t)(row0 + tl) * 512 + 8 * lane) = pack8(y0, y1);
            }
        }
        __syncthreads();
    }
#undef CONV_LOAD
    {
        const size_t gt = (size_t)blockIdx.x * 512 + tid, NGT = (size_t)gridDim.x * 512;
        for (size_t e = gt; e < (size_t)(16 + 32) * 30 * 512; e += NGT) {
            if (e < (size_t)16 * 30 * 512) { const int b = (int)(e / (30 * 512)), i = (int)((e / 512) % 30), c = (int)(e & 511);
                p.out[OUT_CVP + e] = __uint_as_float((unsigned)U[(size_t)(b * TP + TP - 30 + i) * 512 + c] << 16); }
            else { const size_t f = e - (size_t)16 * 30 * 512; const int sbb = (int)(f / (30 * 512)), i = (int)((f / 512) % 30), c = (int)(f & 511);
                p.out[OUT_CVS + f] = i < 14 ? p.in[6][((size_t)sbb * 30 + 16 + i) * 512 + c] : __uint_as_float((unsigned)U[(size_t)(MP + sbb * 16 + i - 14) * 512 + c] << 16); }
        }
    }
}

constexpr int AK_PITCH = 208, AV_PITCH = 136, AK_BYTES = 64 * AK_PITCH, AV_BYTES = 64 * AV_PITCH, AV_OFF = 2 * AK_BYTES;
constexpr float ATT_THR = 6.0f;
__device__ __forceinline__ float rowmax32(const f32x16& a, const f32x16& b) {
    float m0 = __builtin_fmaxf(__builtin_fmaxf(a[0], a[1]), b[0]), m1 = __builtin_fmaxf(__builtin_fmaxf(a[2], a[3]), b[1]);
    m0 = __builtin_fmaxf(__builtin_fmaxf(m0, b[2]), b[3]);
#pragma unroll
    for (int r = 4; r < 16; r += 4) { m0 = __builtin_fmaxf(__builtin_fmaxf(m0, a[r]), a[r + 1]); m1 = __builtin_fmaxf(__builtin_fmaxf(m1, a[r + 2]), a[r + 3]);
        m0 = __builtin_fmaxf(__builtin_fmaxf(m0, b[r]), b[r + 1]); m1 = __builtin_fmaxf(__builtin_fmaxf(m1, b[r + 2]), b[r + 3]); }
    const float m = __builtin_fmaxf(m0, m1);
    auto rr = __builtin_amdgcn_permlane32_swap(__float_as_uint(m), __float_as_uint(m), false, false);
    return __builtin_fmaxf(__uint_as_float(rr[0]), __uint_as_float(rr[1]));
}
__device__ __forceinline__ void attn_unit(LAS unsigned char* lds, const bf16_t* QB, const bf16_t* KB, const bf16_t* VT, bf16_t* O,
                                          int qrow0, int nq_valid, int qpos0, int kvrow0, int ntiles, int kvlen, int h, bool causal) {
    const int tid = threadIdx.x, lane = tid & 63, ql = lane & 31, hi = lane >> 5;
    const int wid = __builtin_amdgcn_readfirstlane(tid >> 6);
    const bool wactive = 32 * wid < nq_valid;
    const int tlim = causal ? ((qpos0 + 32 * wid) >> 6) : (ntiles - 1);
    int qr = qrow0 + 32 * wid + ql; qr = qr < MT ? qr : MT - 1;
    const bf16_t* qp = QB + (size_t)qr * 768 + h * 96 + 8 * hi;
    bf16x8 qf[6];
#pragma unroll
    for (int j = 0; j < 6; ++j) qf[j] = *(const bf16x8*)(qp + 16 * j);
    const int kr0 = tid / 12, kc0 = tid % 12, kr1 = (tid + 512) / 12, kc1 = (tid + 512) % 12, vr = tid >> 3, vc = tid & 7;
    const bf16_t* kg0 = KB + (size_t)(kvrow0 + kr0) * 768 + h * 96 + kc0 * 8;
    const bf16_t* kg1 = KB + (size_t)(kvrow0 + kr1) * 768 + h * 96 + kc1 * 8;
    const bf16_t* vg = VT + (size_t)(h * 64 + vr) * VT_LD + kvrow0 + vc * 8;
    const int kl0 = kr0 * AK_PITCH + kc0 * 16, kl1 = kr1 * AK_PITCH + kc1 * 16, vl = AV_OFF + vr * AV_PITCH + vc * 16;
    u32x4 rk0, rk1 = {0u, 0u, 0u, 0u}, rv;
#define A_LOADK(t) do { rk0 = *(const u32x4*)(kg0 + (size_t)(t) * 64 * 768); if (tid < 256) rk1 = *(const u32x4*)(kg1 + (size_t)(t) * 64 * 768); } while (0)
#define A_LOADV(t) do { rv = *(const u32x4*)(vg + (t) * 64); } while (0)
#define A_STOREK(b) do { *(LAS u32x4*)(lds + (b) * AK_BYTES + kl0) = rk0; if (tid < 256) *(LAS u32x4*)(lds + (b) * AK_BYTES + kl1) = rk1; } while (0)
#define A_STOREV(b) do { *(LAS u32x2*)(lds + (b) * AV_BYTES + vl) = (u32x2){rv.x, rv.y}; *(LAS u32x2*)(lds + (b) * AV_BYTES + vl + 8) = (u32x2){rv.z, rv.w}; } while (0)
#define QK_TILE(S0, S1, buf) do { const LAS unsigned char* kb_ = lds + (buf) * AK_BYTES + ql * AK_PITCH + hi * 16; \
        _Pragma("unroll") for (int r_ = 0; r_ < 16; ++r_) { S0[r_] = -mref; S1[r_] = -mref; } \
        _Pragma("unroll") for (int j_ = 0; j_ < 6; ++j_) { \
            const bf16x8 ka_ = *(const LAS bf16x8*)(kb_ + j_ * 32), kb2_ = *(const LAS bf16x8*)(kb_ + 32 * AK_PITCH + j_ * 32); \
            S0 = __builtin_amdgcn_mfma_f32_32x32x16_bf16(ka_, qf[j_], S0, 0, 0, 0); S1 = __builtin_amdgcn_mfma_f32_32x32x16_bf16(kb2_, qf[j_], S1, 0, 0, 0); } } while (0)
#define KMASK(S0, S1, t) do { if ((t) * 64 + 64 > kvlen) { _Pragma("unroll") for (int r_ = 0; r_ < 16; ++r_) { const int key_ = (t) * 64 + (r_ & 3) + 8 * (r_ >> 2) + 4 * hi; \
        if (key_ >= kvlen) S0[r_] = -1e30f; if (key_ + 32 >= kvlen) S1[r_] = -1e30f; } } } while (0)
    float mref = 0.f, lrun = 0.f;
    f32x16 o0, o1, sc0, sc1, sn0, sn1;
#pragma unroll
    for (int r = 0; r < 16; ++r) { o0[r] = 0.f; o1[r] = 0.f; sc0[r] = 0.f; sc1[r] = 0.f; }
    A_LOADK(0); A_LOADV(0); A_STOREK(0); A_STOREV(0);
    __syncthreads();
    if (ntiles > 1) A_LOADK(1);
    if (wactive) {
        QK_TILE(sc0, sc1, 0); KMASK(sc0, sc1, 0);
        const float mx = rowmax32(sc0, sc1); mref = mx;
#pragma unroll
        for (int r = 0; r < 16; ++r) { sc0[r] -= mx; sc1[r] -= mx; }
    }
    if (ntiles > 1) A_STOREK(1);
    __syncthreads();
    for (int t = 0; t < ntiles; ++t) {
        if (t + 2 < ntiles) A_LOADK(t + 2);
        if (t + 1 < ntiles) A_LOADV(t + 1);
        if (wactive && t <= tlim) {
            bf16x8 kf[12];
            const LAS unsigned char* kbq = lds + ((t + 1) & 1) * AK_BYTES + ql * AK_PITCH + hi * 16;
            { const LAS unsigned char* kb_ = lds + ((t + 1) & 1) * AK_BYTES + ql * AK_PITCH + hi * 16;
#pragma unroll
              for (int j = 0; j < 4; ++j) { kf[2 * j] = *(const LAS bf16x8*)(kb_ + j * 32); kf[2 * j + 1] = *(const LAS bf16x8*)(kb_ + 32 * AK_PITCH + j * 32); }
            }
            __builtin_amdgcn_sched_barrier(0);
            if (t > 0) {
                KMASK(sc0, sc1, t);
                const float mx = rowmax32(sc0, sc1);
                if (__builtin_expect(__any(mx > ATT_THR), 0)) {
                    const float dl = __builtin_fmaxf(mx, 0.f), f = __builtin_amdgcn_exp2f(-dl);
                    mref += dl; lrun *= f;
#pragma unroll
                    for (int r = 0; r < 16; ++r) { sc0[r] -= dl; sc1[r] -= dl; o0[r] *= f; o1[r] *= f; }
                }
            }
#pragma unroll
            for (int r = 0; r < 16; ++r) { sn0[r] = -mref; sn1[r] = -mref; }
#pragma unroll
            for (int j = 4; j < 6; ++j) { kf[2 * j] = *(const LAS bf16x8*)(kbq + j * 32); kf[2 * j + 1] = *(const LAS bf16x8*)(kbq + 32 * AK_PITCH + j * 32); }
#pragma unroll
            for (int j = 0; j < 6; ++j) { sn0 = __builtin_amdgcn_mfma_f32_32x32x16_bf16(kf[2 * j], qf[j], sn0, 0, 0, 0); sn1 = __builtin_amdgcn_mfma_f32_32x32x16_bf16(kf[2 * j + 1], qf[j], sn1, 0, 0, 0); }
            float ls = 0.f;
#pragma unroll
            for (int r = 0; r < 16; ++r) { sc0[r] = __builtin_amdgcn_exp2f(sc0[r]); sc1[r] = __builtin_amdgcn_exp2f(sc1[r]); ls += sc0[r] + sc1[r]; }
            lrun += ls;
            bf16x8 pf[4];
#pragma unroll
            for (int jp = 0; jp < 2; ++jp) {
                u32x4 w; w.x = pk2(sc0[8 * jp + 0], sc0[8 * jp + 1]); w.y = pk2(sc0[8 * jp + 2], sc0[8 * jp + 3]); w.z = pk2(sc0[8 * jp + 4], sc0[8 * jp + 5]); w.w = pk2(sc0[8 * jp + 6], sc0[8 * jp + 7]);
                pf[jp] = __builtin_bit_cast(bf16x8, w);
                u32x4 x; x.x = pk2(sc1[8 * jp + 0], sc1[8 * jp + 1]); x.y = pk2(sc1[8 * jp + 2], sc1[8 * jp + 3]); x.z = pk2(sc1[8 * jp + 4], sc1[8 * jp + 5]); x.w = pk2(sc1[8 * jp + 6], sc1[8 * jp + 7]);
                pf[2 + jp] = __builtin_bit_cast(bf16x8, x);
            }
            __builtin_amdgcn_sched_barrier(0);
            u32x2 vf[16];
            { const LAS unsigned char* vb_ = lds + AV_OFF + (t & 1) * AV_BYTES + ql * AV_PITCH + hi * 8;
#pragma unroll
              for (int jp = 0; jp < 4; ++jp) { vf[4 * jp] = *(const LAS u32x2*)(vb_ + jp * 32); vf[4 * jp + 1] = *(const LAS u32x2*)(vb_ + jp * 32 + 16);
                  vf[4 * jp + 2] = *(const LAS u32x2*)(vb_ + 32 * AV_PITCH + jp * 32); vf[4 * jp + 3] = *(const LAS u32x2*)(vb_ + 32 * AV_PITCH + jp * 32 + 16); } }
#pragma unroll
            for (int jp = 0; jp < 4; ++jp) {
                const u32x2 a0 = vf[4 * jp], a1 = vf[4 * jp + 1], c0 = vf[4 * jp + 2], c1 = vf[4 * jp + 3];
                const bf16x8 va = __builtin_bit_cast(bf16x8, (u32x4){a0.x, a0.y, a1.x, a1.y}), vc2 = __builtin_bit_cast(bf16x8, (u32x4){c0.x, c0.y, c1.x, c1.y});
                o0 = __builtin_amdgcn_mfma_f32_32x32x16_bf16(va, pf[jp], o0, 0, 0, 0);
                o1 = __builtin_amdgcn_mfma_f32_32x32x16_bf16(vc2, pf[jp], o1, 0, 0, 0);
            }
            sc0 = sn0; sc1 = sn1;
        }
        if (t + 2 < ntiles) A_STOREK(t & 1);
        if (t + 1 < ntiles) A_STOREV((t + 1) & 1);
        __syncthreads();
    }
#undef A_LOADK
#undef A_LOADV
#undef A_STOREK
#undef A_STOREV
#undef QK_TILE
#undef KMASK
    float lt;
    { auto rr = __builtin_amdgcn_permlane32_swap(__float_as_uint(lrun), __float_as_uint(lrun), false, false); lt = __uint_as_float(rr[0]) + __uint_as_float(rr[1]); }
    if (wactive && (32 * wid + ql) < nq_valid) {
        const float inv = 1.0f / lt;
        bf16_t* op = O + (size_t)(qrow0 + 32 * wid + ql) * 512 + h * 64 + 4 * hi;
#pragma unroll
        for (int g = 0; g < 4; ++g) {
            u32x2 w0, w1; w0.x = pk2(o0[4 * g] * inv, o0[4 * g + 1] * inv); w0.y = pk2(o0[4 * g + 2] * inv, o0[4 * g + 3] * inv);
            w1.x = pk2(o1[4 * g] * inv, o1[4 * g + 1] * inv); w1.y = pk2(o1[4 * g + 2] * inv, o1[4 * g + 3] * inv);
            *(u32x2*)(op + 8 * g) = w0; *(u32x2*)(op + 32 + 8 * g) = w1;
        }
    }
}
__device__ __forceinline__ void phase_attn(const Params& p, LAS unsigned char* lds) {
    unsigned char* ws = p.ws;
    const bf16_t* QB = (const bf16_t*)(ws + WS_QB); const bf16_t* KB = (const bf16_t*)(ws + WS_KB); const bf16_t* VT = (const bf16_t*)(ws + WS_VT); bf16_t* O = (bf16_t*)(ws + WS_O);
    const bool swz = (gridDim.x == 256);
    for (int v0 = blockIdx.x; v0 < 256; v0 += gridDim.x) {
        const int v = swz ? ((v0 & 7) * 32 + (v0 >> 3)) : v0;
        const int bh = v >> 1, par = v & 1, b = bh >> 3, h = bh & 7;
        for (int i = 0; i < 8; ++i) {
            const int jj = 2 * (i >> 1) + par, qb = (i & 1) ? 15 - jj : jj;
            attn_unit(lds, QB, KB, VT, O, b * TP + qb * 256, 256, qb * 256, b * TP, 4 * qb + 4, 1 << 30, h, true);
        }
        const int sb = v >> 3, sh = v & 7;
        attn_unit(lds, QB, KB, VT, O, MP + sb * TS, TS, 0, MP + sb * KVSEQ, (KVSEQ + 63) / 64, KVSEQ, sh, false);
    }
}

__device__ __forceinline__ void phase_final(const Params& p) {
    const int tid = threadIdx.x, lane = tid & 63, wave = tid >> 6;
    const int gw = blockIdx.x * 8 + wave, NGW = gridDim.x * 8;
    const float* slots = (const float*)(p.ws + WS_SLOT3); const float* g = p.in[27];
    f32x4 gv[4];
#pragma unroll
    for (int j = 0; j < 4; ++j) gv[j] = *(const f32x4*)(g + 4 * lane + 256 * j);
    for (int row = gw; row < MT; row += 2 * NGW) {
        const int rowb = row + NGW; const bool vb = rowb < MT; const int rb = vb ? rowb : row;
        float* x = p.out + OUT_Y + (size_t)row * 1024; float* y = p.out + OUT_Y + (size_t)rb * 1024;
        f32x4 v[4], u[4];
#pragma unroll
        for (int j = 0; j < 4; ++j) { v[j] = *(const f32x4*)(x + 4 * lane + 256 * j); u[j] = *(const f32x4*)(y + 4 * lane + 256 * j); }
        const float rs = rs_from_slots(slots + (size_t)row * 16, 1.0f / 1024.0f, RMS_EPS), rt = rs_from_slots(slots + (size_t)rb * 16, 1.0f / 1024.0f, RMS_EPS);
#pragma unroll
        for (int j = 0; j < 4; ++j) *(f32x4*)(x + 4 * lane + 256 * j) = v[j] * rs * gv[j];
        if (vb) {
#pragma unroll
            for (int j = 0; j < 4; ++j) *(f32x4*)(y + 4 * lane + 256 * j) = u[j] * rt * gv[j];
        }
    }
}

#define XB_TMO      128
#define XB_XCNT(j)  (256  + 64 * (j))
#define XB_XSUB(j)  (1280 + 64 * (j))
#define XB_XGEN(j)  (2304 + 64 * (j))
#define XB_TOP      3328
#define XB_TOPGEN   3392
#define XCD_BAR_WORDS 3456
#define XB_SPIN_CAP (1u << 18)

__device__ __forceinline__ unsigned xb_ld(unsigned* p)              { return __hip_atomic_load(p, __ATOMIC_RELAXED, __HIP_MEMORY_SCOPE_AGENT); }
__device__ __forceinline__ unsigned xb_add(unsigned* p, unsigned v) { return __hip_atomic_fetch_add(p, v, __ATOMIC_RELAXED, __HIP_MEMORY_SCOPE_AGENT); }
__device__ __forceinline__ unsigned xb_xcc_id() { return (unsigned)__builtin_amdgcn_s_getreg((3 << 11) | 20) & 0xFu; }
#define XB_SPIN(cond, bar) do { unsigned _sp = 0; while (cond) { __builtin_amdgcn_s_sleep(1); \
    if ((++_sp & 255u) == 0u) { if (xb_ld(&(bar)[XB_TMO])) break; if (_sp > XB_SPIN_CAP) { atomicAdd(&(bar)[XB_TMO], 1u); break; } } } } while (0)

struct XcdBarrier {
    unsigned* bar; unsigned x;
    volatile LAS unsigned* st;
};

__device__ __forceinline__ XcdBarrier xcd_barrier_post(unsigned* bar, volatile LAS unsigned* st) {
    XcdBarrier b; b.bar = bar; b.x = xb_xcc_id(); b.st = st;
    if (threadIdx.x == 0) (void)xb_add(&bar[XB_XCNT(b.x)], 1u);
    return b;
}
__device__ __forceinline__ void xcd_barrier_complete(unsigned* bar, unsigned x, unsigned& nloc, unsigned& nx) {
    const unsigned G = gridDim.x * gridDim.y * gridDim.z;
    unsigned sum, cnt, mine, sp = 0u;
    for (;;) {
        sum = 0u; cnt = 0u; mine = 0u;
#pragma unroll
        for (unsigned j = 0; j < 16; ++j) { const unsigned c = xb_ld(&bar[XB_XCNT(j)]); sum += c; cnt += (c > 0u) ? 1u : 0u; mine = (j == x) ? c : mine; }
        if (sum == G) break;
        __builtin_amdgcn_s_sleep(1);
        if ((++sp & 255u) == 0u) { if (xb_ld(&bar[XB_TMO])) break; if (sp > XB_SPIN_CAP) { atomicAdd(&bar[XB_TMO], 1u); break; } }
    }
    nloc = mine > 0u ? mine : 1u; nx = cnt > 0u ? cnt : 1u;
}

__device__ __forceinline__ void xcd_barrier(const XcdBarrier& b) {
    asm volatile("s_waitcnt vmcnt(0)" ::: "memory");
    __syncthreads();
    if (threadIdx.x == 0) {
        unsigned* bar = b.bar;
        __builtin_amdgcn_s_waitcnt(0);
        unsigned nloc = b.st[0], nx = b.st[1];
        if (nloc == 0u) { xcd_barrier_complete(bar, b.x, nloc, nx); b.st[0] = nloc; b.st[1] = nx; }
        const unsigned old = xb_add(&bar[XB_XSUB(b.x)], 1u);
        const unsigned gen = old / nloc;
        if (old + 1u == (gen + 1u) * nloc) {
            __builtin_amdgcn_fence(__ATOMIC_RELEASE, "agent");
            asm volatile("s_waitcnt vmcnt(0)" ::: "memory");
            const unsigned og = xb_add(&bar[XB_TOP], 1u);
            const unsigned tg = og / nx;
            if (og + 1u == (tg + 1u) * nx) xb_add(&bar[XB_TOPGEN], 1u);
            else XB_SPIN(xb_ld(&bar[XB_TOPGEN]) == tg, bar);
            __builtin_amdgcn_fence(__ATOMIC_ACQUIRE, "agent");
            xb_add(&bar[XB_XGEN(b.x)], 1u);
            asm volatile("s_waitcnt vmcnt(0)" ::: "memory");
        } else {
            XB_SPIN(xb_ld(&bar[XB_XGEN(b.x)]) == gen, bar);
            __builtin_amdgcn_fence(__ATOMIC_ACQUIRE, "agent");
            asm volatile("s_waitcnt vmcnt(0)" ::: "memory");
        }
    }
    __syncthreads();
}


__global__ void __launch_bounds__(512, 2) mega_fwd(Params p) {
    extern __shared__ __attribute__((aligned(16))) unsigned char lds_raw[];
    LAS unsigned char* lds = (LAS unsigned char*)lds_raw;
    cg::grid_group grid = cg::this_grid();
    unsigned char* ws = p.ws;
    volatile LAS unsigned* xst = (volatile LAS unsigned*)(lds + 131072);
    if (threadIdx.x < 2) xst[threadIdx.x] = 0u;
    __syncthreads();
    XcdBarrier xbar = xcd_barrier_post((unsigned*)(ws + WS_BAR), xst);
    grid.sync();
    const int lo = p.ph_lo, hi = p.ph_hi;
#define IN(k) (lo <= (k) && (k) < hi)
#define SEAM(k) do { if (IN(k) && IN((k) + 1)) { xcd_barrier(xbar); } } while (0)
    bf16_t* G = (bf16_t*)(p.out + OUT_Y);
    if (IN(0)) { phase0(p, lds); }
    SEAM(0);
    const int G_ = (int)gridDim.x, bx_ = (int)blockIdx.x;
#define TAIL_SPLIT(units, nx, vb, vg) const int nx = (units) % G_; const int vb = bx_ - nx, vg = G_ - nx
    if (IN(1)) { EpiIn E{(bf16_t*)(ws + WS_ZS), (bf16_t*)(ws + WS_U), G, (float*)(ws + WS_SLOTQ)}; run_gemm(lds, (const bf16_t*)(ws + WS_XN), (const bf16_t*)(ws + WS_WIN), MT, NZ, 1024, E);
        TAIL_SPLIT((MT / 256) * (NZ / 256), nx1, vb1, vg1); if (vb1 >= 0) phase_cache(p, vb1, vg1, 1); }
    SEAM(1);
    if (IN(2)) { phase_mid_tokens(p); phase_mid_conv(p, lds); }
    SEAM(2);
    if (IN(3)) {
        { EpiQ E{(bf16_t*)(ws + WS_QB), (const float*)(ws + WS_ROPE), (const float*)(ws + WS_SLOTQ)}; run_gemm(lds, (const bf16_t*)(ws + WS_ZS), (const bf16_t*)(ws + WS_WUQ), MT, 768, QL, E, 0, ZW); }
        { EpiK E{(bf16_t*)(ws + WS_KB)}; run_gemm(lds, (const bf16_t*)(ws + WS_LATKV), (const bf16_t*)(ws + WS_WUK), MKV, 512, 256, E, 248); }
        { EpiStore E{(bf16_t*)(ws + WS_VT), (size_t)VT_LD}; run_gemm(lds, (const bf16_t*)(ws + WS_WUV), (const bf16_t*)(ws + WS_LATKV), 512, MKV, 256, E); }
        { TAIL_SPLIT(2 * (MKV / 256), nx3, vb3, vg3); if (vb3 >= 0) phase_cache(p, vb3, vg3, 2); }
    }
    SEAM(3);
    if (IN(4)) { phase_attn(p, lds); }
    SEAM(4);
    if (IN(5)) {
        { EpiGate<false> E{(bf16_t*)(ws + WS_M1), G, 0}; run_gemm(lds, (const bf16_t*)(ws + WS_O), (const bf16_t*)(ws + WS_WAO), MT, 1024, 512, E); }
        { EpiGate<true> E{(bf16_t*)(ws + WS_M1), G, 1024}; run_gemm(lds, (const bf16_t*)(ws + WS_CACT), (const bf16_t*)(ws + WS_WCO), MT, 1024, 512, E); }
    }
    SEAM(5);
    if (IN(6)) { EpiRes E{p.in[0], p.in[1], p.out + OUT_Y, (bf16_t*)(ws + WS_XN), (float*)(ws + WS_SLOT1)}; run_gemm(lds, (const bf16_t*)(ws + WS_M1), (const bf16_t*)(ws + WS_WOUT), MT, 1024, 1024, E);
        TAIL_SPLIT((MT / 256) * 4, nx6, vb6, vg6); if (vb6 >= 0) { phase_pbf(p, vb6, vg6); tr_range(p, lds, W_ITEMS_EARLY, W_ITEMS_UP, vb6, vg6); } }
    SEAM(6);
    if (IN(7)) { { EpiUp E{(bf16_t*)(ws + WS_H), (const float*)(ws + WS_SLOT1)}; run_gemm(lds, (const bf16_t*)(ws + WS_XN), (const bf16_t*)(ws + WS_WUP), MT, 4096, 1024, E); }
        TAIL_SPLIT((MT / 256) * 16, nx7, vb7, vg7); if (vb7 >= 0) tr_range(p, lds, W_ITEMS_UP, W_ITEMS_ALL, vb7, vg7); }
    SEAM(7);
    if (IN(8)) { EpiRes E{p.out + OUT_Y, p.out + OUT_Y + (size_t)MP * 1024, p.out + OUT_Y, (bf16_t*)(ws + WS_XN), (float*)(ws + WS_SLOT2)};
        run_gemm(lds, (const bf16_t*)(ws + WS_H), (const bf16_t*)(ws + WS_WDN), MT, 1024, 4096, E);
        TAIL_SPLIT((MT / 256) * 4, nx8, vb8, vg8);
        if (vb8 >= 0) {
            int kk = 256; asm volatile("" : "+s"(kk));
            pg8::Gemm g{(const bf16_t*)(ws + WS_PBF), (const bf16_t*)(ws + WS_WPP), MT, 1024, kk, 256, 256}; pg8::StaticOrder S; S.init(MT, 1024, vg8, vb8);
            EpiStore E{(bf16_t*)(ws + WS_PP), (size_t)1024};
            pg8::gemm_phase<EpiStore, pg8::StaticOrder, true, true>(lds, g, S, E);
        } }
    SEAM(8);
    if (IN(9)) { EpiPle E{p.out + OUT_Y, (const bf16_t*)(ws + WS_PP), (const float*)(ws + WS_SLOT2), (float*)(ws + WS_SLOT3)}; run_gemm(lds, (const bf16_t*)(ws + WS_XN), (const bf16_t*)(ws + WS_WPG), MT, 1024, 1024, E); }
    SEAM(9);
    if (IN(10)) { phase_final(p); }
#undef IN
#undef SEAM
}

extern "C" void kernel_launch(void* const* d_in, const int* in_sizes, int n_in, void* d_out, int out_size, void* d_ws, size_t ws_size, hipStream_t stream) {
    static int grid_blocks = 0;
    if (grid_blocks == 0) {
        int dev = 0, cus = 0, per_cu = 0;
        (void)hipGetDevice(&dev);
        (void)hipDeviceGetAttribute(&cus, hipDeviceAttributeMultiprocessorCount, dev);
        if (hipFuncSetAttribute((const void*)mega_fwd, hipFuncAttributeMaxDynamicSharedMemorySize, LDS_BYTES) != hipSuccess) fprintf(stderr, "kernel_launch: hipFuncSetAttribute failed\n");
        if (hipOccupancyMaxActiveBlocksPerMultiprocessor(&per_cu, (const void*)mega_fwd, 512, LDS_BYTES) != hipSuccess || per_cu < 1) { fprintf(stderr, "kernel_launch: occupancy query says %d\n", per_cu); per_cu = 1; }
        (void)hipGetLastError();
        grid_blocks = cus * (per_cu > 1 ? 1 : per_cu);
        if (grid_blocks <= 0) grid_blocks = 256;
        if (n_in != 28 || ws_size < ((size_t)1 << 30)) fprintf(stderr, "kernel_launch: unexpected n_in %d / ws_size %zu\n", n_in, ws_size);
    }
    Params p{};
    for (int i = 0; i < 28; ++i) p.in[i] = (const float*)d_in[i];
    p.out = (float*)d_out; p.ws = (unsigned char*)d_ws; p.ph_lo = 0; p.ph_hi = 11;
    (void)hipMemsetAsync((unsigned char*)d_ws + WS_BAR, 0, 16384, stream);
    void* args[] = {&p};
    hipError_t e = hipLaunchCooperativeKernel((const void*)mega_fwd, dim3(grid_blocks), dim3(512), args, LDS_BYTES, stream);
    if (e != hipSuccess) fprintf(stderr, "cooperative launch failed: %s (grid %d)\n", hipGetErrorString(e), grid_blocks);
}
```
